# Optimizing an MI355X kernel written in HIP

```python
import jax, jax.numpy as jnp
from jax import lax
import numpy as np

D_MODEL = 2048
BATCH = 4
SEQ = 4096
DEPTH = 1

GRID_W = 64
MEM_LEN = 256

ATT_HEAD_DIM = 128
ATT_WIDTH = D_MODEL // 2
ATT_HEADS = ATT_WIDTH // ATT_HEAD_DIM
ATT_KV_HEADS = 2
Q_BLOCK = 128
ROPE_THETA = 10000.0

ML_WIDTH = D_MODEL - ATT_WIDTH
ML_HEADS = 4
ML_V_DIM = ML_WIDTH // ML_HEADS
ML_QK_DIM = ML_V_DIM // 2
ML_CHUNK = 64

MIX_WIDTH = ATT_WIDTH + ML_WIDTH
IN_SPLITS = (ATT_WIDTH, ATT_KV_HEADS * ATT_HEAD_DIM, ATT_KV_HEADS * ATT_HEAD_DIM,
             ML_HEADS * ML_QK_DIM, ML_HEADS * ML_QK_DIM, ML_WIDTH, ML_WIDTH,
             2 * ML_HEADS, 2 * ML_HEADS)
IN_TOTAL = sum(IN_SPLITS)

XA_HEADS = 4
XA_HEAD_DIM = D_MODEL // XA_HEADS

PEER_HEADS = 8
PEER_NKEYS = 128
PEER_EXPERTS = PEER_NKEYS * PEER_NKEYS
PEER_TOPK = 16
PEER_QDIM = 256
PEER_BLOCK = 128

ALPHA = (2.0 * DEPTH) ** 0.25
BETA = (8.0 * DEPTH) ** -0.25

LN_EPS = 1e-5
RMS_EPS = 1e-6

kernel_name = "hybrid_attn_mlstm_peer_encoder"


def _layer_norm(x, g, b):
    xf = x.astype(jnp.float32)
    xc = xf - jnp.mean(xf, -1, keepdims=True)
    var = jnp.mean(xc * xc, -1, keepdims=True)
    y = xc * lax.rsqrt(var + LN_EPS) * g.astype(jnp.float32) + b.astype(jnp.float32)
    return y.astype(x.dtype)


def _rms_norm(x, g):
    xf = x.astype(jnp.float32)
    return xf * lax.rsqrt(jnp.mean(xf * xf, -1, keepdims=True) + RMS_EPS) * g.astype(jnp.float32)


def _axial_rope_tables(seq_len):
    rows = seq_len // GRID_W
    row = jnp.repeat(jnp.arange(rows, dtype=jnp.float32), GRID_W)
    col = jnp.tile(jnp.arange(GRID_W, dtype=jnp.float32), rows)
    n_freq = ATT_HEAD_DIM // 4
    inv_freq = ROPE_THETA ** (-jnp.arange(n_freq, dtype=jnp.float32) / n_freq)
    ang_r = row[:, None] * inv_freq
    ang_c = col[:, None] * inv_freq
    return (jnp.cos(ang_r), jnp.sin(ang_r), jnp.cos(ang_c), jnp.sin(ang_c))


def _rotate(z, cos, sin):
    z1, z2 = jnp.split(z, 2, axis=-1)
    c = cos[:, None, :]
    s = sin[:, None, :]
    return jnp.concatenate([z1 * c - z2 * s, z1 * s + z2 * c], axis=-1)


def _apply_axial_rope(z, tables):
    cos_r, sin_r, cos_c, sin_c = tables
    z_row, z_col = jnp.split(z, 2, axis=-1)
    return jnp.concatenate([_rotate(z_row, cos_r, sin_r), _rotate(z_col, cos_c, sin_c)], axis=-1)


def _blocked_gqa(q, k, v):
    B, S, H, Dh = q.shape
    G = H // ATT_KV_HEADS
    nb = S // Q_BLOCK
    qb = jnp.transpose(q.reshape(B, nb, Q_BLOCK, ATT_KV_HEADS, G, Dh), (1, 0, 2, 3, 4, 5))
    scale = Dh ** -0.5

    def block(q_blk):
        s = jnp.einsum('bqhgd,bkhd->bhgqk', q_blk, k, preferred_element_type=jnp.float32) * scale
        p = jax.nn.softmax(s, axis=-1)
        return jnp.einsum('bhgqk,bkhd->bqhgd', p.astype(v.dtype), v)

    o = lax.map(block, qb)
    return jnp.transpose(o, (1, 0, 2, 3, 4, 5)).reshape(B, S, H * Dh)


def _mlstm_chunkwise(q, k, v, log_f, log_i):
    B, H, S, dk = q.shape
    dv = v.shape[-1]
    L = ML_CHUNK
    nc = S // L

    def to_chunks(a):
        return jnp.moveaxis(a.reshape((B, H, nc, L) + a.shape[3:]), 2, 0)

    within = jnp.tril(jnp.ones((L, L), dtype=bool))

    def step(carry, inp):
        C, n, m = carry
        qc, kc, vc, fc, ic = inp
        b = jnp.cumsum(fc, axis=-1)
        log_d = b[..., :, None] - b[..., None, :] + ic[..., None, :]
        log_d = jnp.where(within, log_d, -jnp.inf)
        log_inter = b + m[..., None]
        m_row = jnp.maximum(log_inter, jnp.max(log_d, axis=-1))
        d = jnp.exp(log_d - m_row[..., None])
        w_inter = jnp.exp(log_inter - m_row)
        qk = jnp.einsum('bhld,bhsd->bhls', qc, kc) * d
        num = jnp.einsum('bhls,bhse->bhle', qk, vc) + w_inter[..., None] * jnp.einsum('bhld,bhde->bhle', qc, C)
        den = jnp.sum(qk, axis=-1) + w_inter * jnp.einsum('bhld,bhd->bhl', qc, n)
        h = num / jnp.maximum(jnp.abs(den), jnp.exp(-m_row))[..., None]
        b_last = b[..., -1]
        log_w = b_last[..., None] - b + ic
        m_new = jnp.maximum(b_last + m, jnp.max(log_w, axis=-1))
        w = jnp.exp(log_w - m_new[..., None])
        decay = jnp.exp(b_last + m - m_new)
        C = decay[..., None, None] * C + jnp.einsum('bhs,bhsd,bhse->bhde', w, kc, vc)
        n = decay[..., None] * n + jnp.einsum('bhs,bhsd->bhd', w, kc)
        return (C, n, m_new), h

    init = (jnp.zeros((B, H, dk, dv), jnp.float32), jnp.zeros((B, H, dk), jnp.float32),
            jnp.zeros((B, H), jnp.float32))
    _, h = lax.scan(step, init, (to_chunks(q), to_chunks(k), to_chunks(v), to_chunks(log_f), to_chunks(log_i)))
    return jnp.moveaxis(h, 0, 2).reshape(B, H, S, dv)


def _flip_seq(z):
    return jnp.flip(z, axis=2)


def _ml_heads(z, dim):
    B, S, _ = z.shape
    return jnp.transpose(z.reshape(B, S, ML_HEADS, dim).astype(jnp.float32), (0, 2, 1, 3))


def _hybrid_mixer(x, w_in, b_igate, b_fgate, att_q_norm, att_k_norm, ml_norm, w_out):
    B, S, _ = x.shape
    h = x @ w_in
    cuts = np.cumsum(IN_SPLITS)[:-1].tolist()
    aq, ak, av, mq, mk, mv, mo, gi, gf = jnp.split(h, cuts, axis=-1)

    tables = _axial_rope_tables(S)
    aq = _apply_axial_rope(_rms_norm(aq.reshape(B, S, ATT_HEADS, ATT_HEAD_DIM), att_q_norm), tables).astype(x.dtype)
    ak = _apply_axial_rope(_rms_norm(ak.reshape(B, S, ATT_KV_HEADS, ATT_HEAD_DIM), att_k_norm), tables).astype(x.dtype)
    av = av.reshape(B, S, ATT_KV_HEADS, ATT_HEAD_DIM)
    att = _blocked_gqa(aq, ak, av)

    mq = _ml_heads(mq, ML_QK_DIM)
    mk = _ml_heads(mk, ML_QK_DIM) * (ML_QK_DIM ** -0.5)
    mv = _ml_heads(mv, ML_V_DIM)
    log_i = jnp.transpose((gi.reshape(B, S, 2, ML_HEADS) + b_igate).astype(jnp.float32), (2, 0, 3, 1))
    log_f = jnp.transpose(jax.nn.log_sigmoid((gf.reshape(B, S, 2, ML_HEADS) + b_fgate).astype(jnp.float32)), (2, 0, 3, 1))
    h_fwd = _mlstm_chunkwise(mq, mk, mv, log_f[0], log_i[0])
    h_bwd = _flip_seq(_mlstm_chunkwise(_flip_seq(mq), _flip_seq(mk), _flip_seq(mv),
                                       _flip_seq(log_f[1]), _flip_seq(log_i[1])))
    hm = jnp.transpose(h_fwd + h_bwd, (0, 2, 1, 3))
    hm = _rms_norm(hm, ml_norm.reshape(ML_HEADS, ML_V_DIM)).reshape(B, S, ML_WIDTH)
    ml = (hm * jax.nn.sigmoid(mo.astype(jnp.float32))).astype(x.dtype)

    return jnp.concatenate([att, ml], axis=-1) @ w_out


def _memory_cross_attention(x, mem, wq, wk, wv, wo):
    B, S, D = x.shape
    M = mem.shape[1]
    q = (x @ wq).reshape(B, S, XA_HEADS, XA_HEAD_DIM)
    k = (mem @ wk).reshape(B, M, XA_HEADS, XA_HEAD_DIM)
    v = (mem @ wv).reshape(B, M, XA_HEADS, XA_HEAD_DIM)
    s = jnp.einsum('bqhd,bkhd->bhqk', q, k, preferred_element_type=jnp.float32) * (XA_HEAD_DIM ** -0.5)
    p = jax.nn.softmax(s, axis=-1)
    o = jnp.einsum('bhqk,bkhd->bqhd', p.astype(v.dtype), v).reshape(B, S, D)
    return o @ wo


def _peer(x, wq, subkeys, u, v):
    B, S, D = x.shape
    T = B * S
    xt = x.reshape(T, D)
    q = (xt @ wq).reshape(T, PEER_HEADS, 2, PEER_QDIM // 2)
    s = jnp.einsum('thcd,hckd->thck', q, subkeys).astype(jnp.float32)
    top_s, top_i = lax.top_k(s, PEER_TOPK)
    cand_s = top_s[:, :, 0, :, None] + top_s[:, :, 1, None, :]
    cand_e = top_i[:, :, 0, :, None] * PEER_NKEYS + top_i[:, :, 1, None, :]
    best_s, best_pos = lax.top_k(cand_s.reshape(T, PEER_HEADS, PEER_TOPK * PEER_TOPK), PEER_TOPK)
    experts = jnp.take_along_axis(cand_e.reshape(T, PEER_HEADS, PEER_TOPK * PEER_TOPK), best_pos, axis=-1)
    gates = jax.nn.softmax(best_s, axis=-1)
    E = PEER_HEADS * PEER_TOPK
    nb = T // PEER_BLOCK
    experts = experts.reshape(nb, PEER_BLOCK, E)
    gates = gates.reshape(nb, PEER_BLOCK, E).astype(x.dtype)

    def block(args):
        xb, eb, gb = args
        a = jax.nn.gelu(jnp.einsum('ted,td->te', u[eb], xb), approximate=False) * gb
        return jnp.einsum('te,ted->td', a, v[eb])

    out = lax.map(block, (xt.reshape(nb, PEER_BLOCK, D), experts, gates))
    return out.reshape(B, S, D)


def setup_inputs(seed: int = 0) -> dict:
    key = jax.random.key(seed)
    ks = jax.random.split(key, 23)
    f32 = jnp.float32
    D = D_MODEL

    def nrm(k, shape, scale):
        return jax.random.normal(k, shape, f32) * scale

    def gain(k, shape):
        return 1.0 + 0.02 * jax.random.normal(k, shape, f32)

    def bias(k, shape):
        return 0.02 * jax.random.normal(k, shape, f32)

    col_scale = jnp.asarray(np.concatenate(
        [np.full((n,), BETA if i in (2, 5) else 1.0, dtype=np.float32) for i, n in enumerate(IN_SPLITS)]))
    return {
        'x': nrm(ks[0], (BATCH, SEQ, D), 1.0),
        'mem': nrm(ks[1], (BATCH, MEM_LEN, D), 1.0),
        'w_in': nrm(ks[2], (DEPTH, D, IN_TOTAL), D ** -0.5) * col_scale,
        'b_igate': -1.0 + 0.1 * jax.random.normal(ks[3], (DEPTH, 2, ML_HEADS), f32),
        'b_fgate': jnp.linspace(3.0, 6.0, ML_HEADS, dtype=f32) + 0.1 * jax.random.normal(ks[4], (DEPTH, 2, ML_HEADS), f32),
        'att_q_norm': gain(ks[5], (DEPTH, ATT_HEAD_DIM)),
        'att_k_norm': gain(ks[6], (DEPTH, ATT_HEAD_DIM)),
        'ml_norm': gain(ks[7], (DEPTH, ML_WIDTH)),
        'w_out': nrm(ks[8], (DEPTH, MIX_WIDTH, D), MIX_WIDTH ** -0.5) * BETA,
        'ln1_g': gain(ks[9], (DEPTH, D)),
        'ln1_b': bias(ks[10], (DEPTH, D)),
        'xa_wq': nrm(ks[11], (DEPTH, D, D), D ** -0.5),
        'xa_wk': nrm(ks[12], (DEPTH, D, D), D ** -0.5),
        'xa_wv': nrm(ks[13], (DEPTH, D, D), D ** -0.5) * BETA,
        'xa_wo': nrm(ks[14], (DEPTH, D, D), D ** -0.5) * BETA,
        'ln2_g': gain(ks[15], (DEPTH, D)),
        'ln2_b': bias(ks[16], (DEPTH, D)),
        'peer_wq': nrm(ks[17], (DEPTH, D, PEER_HEADS * PEER_QDIM), D ** -0.5),
        'peer_subkeys': nrm(ks[18], (DEPTH, PEER_HEADS, 2, PEER_NKEYS, PEER_QDIM // 2), (PEER_QDIM // 2) ** -0.5),
        'peer_u': nrm(ks[19], (DEPTH, PEER_EXPERTS, D), D ** -0.5),
        'peer_v': nrm(ks[20], (DEPTH, PEER_EXPERTS, D), (PEER_HEADS * PEER_TOPK) ** -0.5) * BETA,
        'ln3_g': gain(ks[21], (DEPTH, D)),
        'ln3_b': bias(ks[22], (DEPTH, D)),
    }


def reference(x, mem, w_in, b_igate, b_fgate, att_q_norm, att_k_norm, ml_norm, w_out,
              ln1_g, ln1_b, xa_wq, xa_wk, xa_wv, xa_wo, ln2_g, ln2_b,
              peer_wq, peer_subkeys, peer_u, peer_v, ln3_g, ln3_b):
    for l in range(DEPTH):
        y = _hybrid_mixer(x, w_in[l], b_igate[l], b_fgate[l], att_q_norm[l], att_k_norm[l], ml_norm[l], w_out[l])
        x = _layer_norm(ALPHA * x + y, ln1_g[l], ln1_b[l])
        y = _memory_cross_attention(x, mem, xa_wq[l], xa_wk[l], xa_wv[l], xa_wo[l])
        x = _layer_norm(ALPHA * x + y, ln2_g[l], ln2_b[l])
        y = _peer(x, peer_wq[l], peer_subkeys[l], peer_u[l], peer_v[l])
        x = _layer_norm(ALPHA * x + y, ln3_g[l], ln3_b[l])
    return x
```

```cpp
#include <hip/hip_runtime.h>
#include <hip/hip_bf16.h>
#include <hip/hip_cooperative_groups.h>
#include <cstdio>
#include <cstdint>
namespace cg = cooperative_groups;

#define GAS __attribute__((address_space(1)))
#define LAS __attribute__((address_space(3)))
typedef unsigned short bf16_t;
typedef short bf16x8 __attribute__((ext_vector_type(8)));
typedef short s16x4 __attribute__((ext_vector_type(4)));
typedef float f32x4 __attribute__((ext_vector_type(4)));
typedef float f32x2 __attribute__((ext_vector_type(2)));
typedef float f32x16 __attribute__((ext_vector_type(16)));
typedef unsigned u32x4 __attribute__((ext_vector_type(4)));
typedef unsigned u32x2 __attribute__((ext_vector_type(2)));

constexpr int NB = 4, SEQ = 4096, DM = 2048, NT = NB * SEQ;
constexpr int MEML = 256, NMEM = NB * MEML;
constexpr int IN_TOTAL = 4624, HP = 4608, NPAD = 4864;
constexpr int C_AQ = 0, C_AK = 1024, C_AV = 1280, C_MQ = 1536, C_MK = 2048, C_MV = 2560, C_MO = 3584, C_G = 4608;
constexpr int NEXP = 16384;
constexpr float ALPHA = 1.189207115002721f;
constexpr float LN_EPS = 1e-5f, RMS_EPS = 1e-6f;
constexpr int NWAVES = 8, NTHREADS = 512;

constexpr size_t MiB = 1u << 20;
constexpr size_t WS_CTL = 0, CTL_ZERO_BYTES = 65536;
constexpr size_t WS_WIN = 2 * MiB;
constexpr size_t WS_WOUT = 22 * MiB, WS_XWQ = 30 * MiB, WS_XWK = 38 * MiB, WS_XWV = 46 * MiB, WS_XWO = 54 * MiB, WS_PWQ = 62 * MiB;
constexpr size_t WS_SK = 70 * MiB;
constexpr size_t WS_MEMB = 71 * MiB;
constexpr size_t WS_K2 = 75 * MiB;
constexpr size_t WS_V2T = 79 * MiB;
constexpr size_t WS_GATES = 83 * MiB;
constexpr size_t WS_EXP = 84 * MiB, WS_PG = 92 * MiB;
constexpr size_t WS_XN = 100 * MiB;
constexpr size_t WS_H = 164 * MiB;
constexpr size_t WS_ZB = WS_H, WS_Q2 = WS_H + 64 * MiB, WS_O2 = WS_H + 64 * MiB, WS_PQ = WS_H + 64 * MiB;
constexpr size_t WS_ST1 = 330 * MiB, WS_ST2 = 336 * MiB;
constexpr size_t WS_CS = 32768;
constexpr size_t WS_CSP = 342 * MiB;
constexpr size_t WS_UB = 308 * MiB, WS_VB = 372 * MiB;
constexpr size_t WS_USC = 1 * MiB, WS_VSC = 1 * MiB + 65536;
constexpr size_t WS_WQN = 400 * MiB;
constexpr size_t WS_MT = 408 * MiB;
constexpr size_t WS_VWT = 424 * MiB;
constexpr size_t WS_CS2 = 1 * MiB + 262144;
constexpr size_t WS_END = 448 * MiB;
constexpr int CW_BAR = 4096;

constexpr int RING_BYTES = 131072;
constexpr int LDSCTL_OFF = 143360;
constexpr int LDS_BYTES = 155648;

#define LDS_WAIT() asm volatile("s_waitcnt lgkmcnt(0)" ::: "memory")
#define VM_WAIT() asm volatile("s_waitcnt vmcnt(0)" ::: "memory")
#define SBAR() __builtin_amdgcn_sched_barrier(0)
__device__ __forceinline__ unsigned f2bf(float f) { unsigned u = __builtin_bit_cast(unsigned, f); return (u + 0x7fffu + ((u >> 16) & 1u)) >> 16; }
__device__ __forceinline__ float bf2f(unsigned short h) { return __builtin_bit_cast(float, (unsigned)h << 16); }
__device__ __forceinline__ float bflo(unsigned w) { return __builtin_bit_cast(float, w << 16); }
__device__ __forceinline__ float bfhi(unsigned w) { return __builtin_bit_cast(float, w & 0xffff0000u); }
typedef __bf16 bf16x2_t __attribute__((ext_vector_type(2)));
__device__ __forceinline__ unsigned cvt_pk_bf16(float lo, float hi) { const f32x2 v = {lo, hi}; return __builtin_bit_cast(unsigned, __builtin_convertvector(v, bf16x2_t)); }
__device__ __forceinline__ unsigned pk2(float lo, float hi) { return cvt_pk_bf16(lo, hi); }
__device__ __forceinline__ float wave_sum(float v) {
#pragma unroll
    for (int o = 1; o < 64; o <<= 1) v += __shfl_xor(v, o);
    return v;
}
__device__ __forceinline__ float wave_max(float v) {
#pragma unroll
    for (int o = 1; o < 64; o <<= 1) v = fmaxf(v, __shfl_xor(v, o));
    return v;
}
__device__ __forceinline__ int crow(int r, int hi) { return (r & 3) + 8 * (r >> 2) + 4 * hi; }

#define XB_TMO      128
#define XB_XCNT(j)  (256  + 64 * (j))
#define XB_XSUB(j)  (1280 + 64 * (j))
#define XB_XGEN(j)  (2304 + 64 * (j))
#define XB_TOP      3328
#define XB_TOPGEN   3392
#define XCD_BAR_WORDS 3456
#define XB_SPIN_CAP (1u << 20)
__device__ __forceinline__ unsigned xb_ld(unsigned* p)              { return __hip_atomic_load((GAS unsigned*)p, __ATOMIC_RELAXED, __HIP_MEMORY_SCOPE_AGENT); }
__device__ __forceinline__ unsigned xb_add(unsigned* p, unsigned v) { return __hip_atomic_fetch_add((GAS unsigned*)p, v, __ATOMIC_RELAXED, __HIP_MEMORY_SCOPE_AGENT); }
__device__ __forceinline__ unsigned xb_xcc_id() { return (unsigned)__builtin_amdgcn_s_getreg((3 << 11) | 20) & 0xFu; }
#define XB_SPIN(cond, bar) do { unsigned _sp = 0; while (cond) { __builtin_amdgcn_s_sleep(1); \
    if ((++_sp & 255u) == 0u) { if (xb_ld(&(bar)[XB_TMO])) break; if (_sp > XB_SPIN_CAP) { (void)xb_add(&(bar)[XB_TMO], 1u); break; } } } } while (0)
struct XcdBarrier { unsigned* bar; unsigned x; volatile LAS unsigned* st; };
__device__ __forceinline__ XcdBarrier xcd_barrier_post(unsigned* bar, volatile LAS unsigned* st, bool leader) {
    XcdBarrier b; b.bar = bar; b.x = xb_xcc_id(); b.st = st;
    if (leader) (void)xb_add(&bar[XB_XCNT(b.x)], 1u);
    return b;
}
__device__ __forceinline__ void xcd_barrier_complete(unsigned* bar, unsigned x, unsigned& nloc, unsigned& nx) {
    const unsigned G = gridDim.x * gridDim.y * gridDim.z;
    unsigned sum, cnt, mine, sp = 0u;
    for (;;) {
        sum = 0u; cnt = 0u; mine = 0u;
#pragma unroll
        for (unsigned j = 0; j < 16; ++j) { const unsigned c = xb_ld(&bar[XB_XCNT(j)]); sum += c; cnt += (c > 0u) ? 1u : 0u; mine = (j == x) ? c : mine; }
        if (sum == G) break;
        __builtin_amdgcn_s_sleep(1);
        if ((++sp & 255u) == 0u) { if (xb_ld(&bar[XB_TMO])) break; if (sp > XB_SPIN_CAP) { (void)xb_add(&bar[XB_TMO], 1u); break; } }
    }
    nloc = mine > 0u ? mine : 1u; nx = cnt > 0u ? cnt : 1u;
}
__device__ __forceinline__ void xcd_barrier(const XcdBarrier& b, bool leader) {
    asm volatile("s_waitcnt vmcnt(0)" ::: "memory");
    __syncthreads();
    if (leader) {
        unsigned* bar = b.bar;
        __builtin_amdgcn_s_waitcnt(0);
        unsigned nloc = b.st[0], nx = b.st[1];
        if (nloc == 0u) { xcd_barrier_complete(bar, b.x, nloc, nx); b.st[0] = nloc; b.st[1] = nx; }
        const unsigned old = xb_add(&bar[XB_XSUB(b.x)], 1u);
        const unsigned gen = old / nloc;
        if (old + 1u == (gen + 1u) * nloc) {
            __builtin_amdgcn_fence(__ATOMIC_RELEASE, "agent");
            asm volatile("s_waitcnt vmcnt(0)" ::: "memory");
            const unsigned og = xb_add(&bar[XB_TOP], 1u);
            const unsigned tg = og / nx;
            if (og + 1u == (tg + 1u) * nx) xb_add(&bar[XB_TOPGEN], 1u);
            else XB_SPIN(xb_ld(&bar[XB_TOPGEN]) == tg, bar);
            __builtin_amdgcn_fence(__ATOMIC_ACQUIRE, "agent");
            xb_add(&bar[XB_XGEN(b.x)], 1u);
            asm volatile("s_waitcnt vmcnt(0)" ::: "memory");
        } else {
            XB_SPIN(xb_ld(&bar[XB_XGEN(b.x)]) == gen, bar);
            __builtin_amdgcn_fence(__ATOMIC_ACQUIRE, "agent");
            asm volatile("s_waitcnt vmcnt(0)" ::: "memory");
        }
    }
    __syncthreads();
}

__device__ __forceinline__ void ctr_barrier(unsigned* cnt, unsigned target, bool leader) {
    asm volatile("s_waitcnt vmcnt(0)" ::: "memory");
    __syncthreads();
    if (leader) {
        __builtin_amdgcn_fence(__ATOMIC_RELEASE, "agent");
        asm volatile("s_waitcnt vmcnt(0)" ::: "memory");
        (void)xb_add(cnt, 1u);
        unsigned sp = 0u;
        while (xb_ld(cnt) < target) { __builtin_amdgcn_s_sleep(2); if (++sp > (1u << 24)) break; }
        __builtin_amdgcn_fence(__ATOMIC_ACQUIRE, "agent");
        asm volatile("s_waitcnt vmcnt(0)" ::: "memory");
    }
    __syncthreads();
}

namespace pg8 {
constexpr int BM = 256, BK = 64, HALF = 128, HTB = HALF * BK * 2, STAGE_BYTES = 8 * HTB, NXCD = 8, WGM = 8;
__host__ __device__ __forceinline__ int lds_byte(int r, int c) { const int st = (r >> 4) * 2 + (c >> 5), rr = r & 15, cc = c & 31, ob = rr * 64 + cc * 2; return st * 1024 + (ob ^ (((ob >> 9) & 1) << 5)); }
__host__ __device__ __forceinline__ void stage_rc(int b, int& R, int& C) { const int st = b / 1024, sb = b % 1024, swz = sb ^ (((sb >> 9) & 1) << 5); R = (st >> 1) * 16 + swz / 64; C = (st & 1) * 32 + (swz % 64) / 2; }
__host__ __device__ __forceinline__ int perm32(int rho) { const int n = rho >> 4, i = rho & 15; return 8 * (i >> 2) + 4 * n + (i & 3); }

struct Unit { int pm, pn; const char* a; const char* b; };
struct Gemm { int lda, ldb, K; };

struct PlainOrder {
    const bf16_t* A; const bf16_t* Bt; int lda, ldb; int nM, nN, nwg, G, c, c0;
    __device__ void init(const bf16_t* A_, const bf16_t* Bt_, int lda_, int ldb_, int M, int N, int G_, int c_, int c0_ = 0) { A = A_; Bt = Bt_; lda = lda_; ldb = ldb_; nM = M / BM; nN = N / BM; nwg = nM * nN; G = G_; c = c_; c0 = c0_; }
    __device__ bool next(int i, Unit& u) const {
        const int cc = c - c0; if (cc < 0) return false;
        const long L = (long)i * G + cc; if (L >= nwg) return false;
        int wgid = (int)L; { const int q = nwg / NXCD, r = nwg % NXCD, xcd = wgid % NXCD, off = wgid / NXCD; wgid = (xcd < r ? xcd * (q + 1) : r * (q + 1) + (xcd - r) * q) + off; }
        const int nig = WGM * nN, gid = wgid / nig, fm = gid * WGM, gsz = (nM - fm) < WGM ? (nM - fm) : WGM;
        u.pm = fm + ((wgid % nig) % gsz); u.pn = (wgid % nig) / gsz;
        u.a = (const char*)(A + (size_t)u.pm * BM * lda); u.b = (const char*)(Bt + (size_t)u.pn * BM * ldb); return true;
    }
};

template <class Epi, class Sched>
__device__ __forceinline__ void gemm_phase(LAS unsigned char* lds, const int tid, const int wid, const Gemm g, const Sched& S, const Epi& E) {
    const int lane = tid & 63, wr = wid >> 2, wc = wid & 3, fr = lane & 15, fq = lane >> 4;
    const int K = g.K, nt = K / BK;
    unsigned voffA[2], voffB[2];
#pragma unroll
    for (int i = 0; i < 2; ++i) { int R, C; stage_rc(tid * 16 + i * 8192, R, C); const int Rb = Epi::PERM ? ((R & ~31) + perm32(R & 31)) : R;
        voffA[i] = (unsigned)(R * g.lda + C) * 2u; voffB[i] = (unsigned)(Rb * g.ldb + C) * 2u; }
    const size_t kstep = (size_t)(BK * 2);
    const size_t hsA = (size_t)HALF * g.lda * 2, hsB = (size_t)HALF * g.ldb * 2;
    const unsigned ldsw = (unsigned)wid * 1024u;
    const int aoff = lds_byte(wr * 64 + fr, fq * 8), boff = lds_byte(wc * 32 + fr, fq * 8);
#define PG8_SA(b, h) (((b) * 2 + (h)) * HTB)
#define PG8_SB(b, h) ((4 + (b) * 2 + (h)) * HTB)
#define PG8_STAGE(bufoff, gbase, voff) do { _Pragma("unroll") for (int _i = 0; _i < 2; ++_i) \
        __builtin_amdgcn_global_load_lds((const unsigned*)((const char*)(gbase) + (voff)[_i]), (LAS unsigned*)(lds + (bufoff) + ldsw + _i * 8192), 16, 0, 0); } while (0)
#define PG8_LDA(dst, b, h) do { _Pragma("unroll") for (int m = 0; m < 4; ++m) _Pragma("unroll") for (int k = 0; k < 2; ++k) dst[m][k] = *(const LAS bf16x8*)(lds + PG8_SA(b, h) + aoff + m * 2048 + k * 1024); } while (0)
#define PG8_LDB(dst, b, h) do { _Pragma("unroll") for (int n = 0; n < 2; ++n) _Pragma("unroll") for (int k = 0; k < 2; ++k) dst[n][k] = *(const LAS bf16x8*)(lds + PG8_SB(b, h) + boff + n * 2048 + k * 1024); } while (0)
#define PG8_MMA(ai, bj, At, Bt) do { __builtin_amdgcn_s_setprio(1); _Pragma("unroll") for (int m = 0; m < 4; ++m) _Pragma("unroll") for (int n = 0; n < 2; ++n) _Pragma("unroll") for (int k = 0; k < 2; ++k) \
        acc[ai][bj][m][n] = __builtin_amdgcn_mfma_f32_16x16x32_bf16(Bt[n][k], At[m][k], acc[ai][bj][m][n], 0, 0, 0); __builtin_amdgcn_s_setprio(0); } while (0)
#define PG8_WAIT_V(n) asm volatile("s_waitcnt vmcnt(" #n ")" ::: "memory")
#define PG8_WAIT_L(n) asm volatile("s_waitcnt lgkmcnt(" #n ")" ::: "memory")
#define PG8_BAR __builtin_amdgcn_s_barrier()
#define PG8_SCHED __builtin_amdgcn_sched_barrier(0)
    Unit cur, nxt; int ui = 0;
    if (!S.next(0, cur)) return;
    f32x4 acc[2][2][4][2];
#pragma unroll
    for (int a = 0; a < 2; ++a)
#pragma unroll
        for (int b = 0; b < 2; ++b)
#pragma unroll
            for (int m = 0; m < 4; ++m)
#pragma unroll
                for (int n = 0; n < 2; ++n) acc[a][b][m][n] = (f32x4){0.f, 0.f, 0.f, 0.f};
    bf16x8 At[4][2], B0[2][2], B1[2][2];
    const char* cA = cur.a; const char* cB = cur.b;
    PG8_STAGE(PG8_SB(0, 0), cB, voffB); PG8_STAGE(PG8_SB(0, 1), cB + hsB, voffB); PG8_STAGE(PG8_SA(0, 0), cA, voffA); PG8_STAGE(PG8_SA(0, 1), cA + hsA, voffA);
    if (wr == 1) PG8_BAR;
    PG8_WAIT_V(2); PG8_BAR;
    PG8_STAGE(PG8_SB(1, 0), cB + kstep, voffB); PG8_STAGE(PG8_SA(1, 0), cA + kstep, voffA); PG8_STAGE(PG8_SB(1, 1), cB + hsB + kstep, voffB);
    PG8_WAIT_V(6); PG8_BAR;
    for (;;) {
        const bool has_next = S.next(ui + 1, nxt);
        const char* nA = has_next ? nxt.a : cA; const char* nB = has_next ? nxt.b : cB;
        for (int t = 0; t < nt; t += 2) {
            const bool last = (t == nt - 2);
            const char* a1 = cA + (size_t)(t + 1) * kstep;
            const char* a2 = last ? nA : cA + (size_t)(t + 2) * kstep; const char* b2 = last ? nB : cB + (size_t)(t + 2) * kstep;
            const char* a3 = a2 + kstep; const char* b3 = b2 + kstep;
            PG8_LDB(B0, 0, 0); PG8_LDB(B1, 0, 1); PG8_SCHED; PG8_LDA(At, 0, 0); PG8_STAGE(PG8_SA(1, 1), a1 + hsA, voffA);
            PG8_WAIT_V(8); PG8_WAIT_L(0); PG8_BAR; PG8_MMA(0, 0, At, B0); PG8_MMA(0, 1, At, B1); PG8_BAR; PG8_SCHED;
            PG8_LDA(At, 0, 1); PG8_STAGE(PG8_SB(0, 0), b2, voffB); PG8_STAGE(PG8_SB(0, 1), b2 + hsB, voffB); PG8_STAGE(PG8_SA(0, 0), a2, voffA);
            PG8_WAIT_V(8); PG8_WAIT_L(0); PG8_BAR; PG8_MMA(1, 0, At, B0); PG8_MMA(1, 1, At, B1); PG8_BAR; PG8_SCHED;
            PG8_LDB(B0, 1, 0); PG8_LDB(B1, 1, 1); PG8_SCHED; PG8_LDA(At, 1, 0); PG8_STAGE(PG8_SA(0, 1), a2 + hsA, voffA);
            PG8_WAIT_V(8); PG8_WAIT_L(0); PG8_BAR; PG8_MMA(0, 0, At, B0); PG8_MMA(0, 1, At, B1); PG8_BAR; PG8_SCHED;
            PG8_LDA(At, 1, 1); PG8_STAGE(PG8_SB(1, 0), b3, voffB); PG8_STAGE(PG8_SB(1, 1), b3 + hsB, voffB); PG8_STAGE(PG8_SA(1, 0), a3, voffA);
            PG8_WAIT_V(8); PG8_WAIT_L(0); PG8_BAR; PG8_MMA(1, 0, At, B0); PG8_MMA(1, 1, At, B1); PG8_BAR; PG8_SCHED;
        }
        if (wr == 0) PG8_BAR;
        E(acc, cur, wr, wc, fr, fq);
        if (!has_next) break;
#pragma unroll
        for (int a = 0; a < 2; ++a)
#pragma unroll
            for (int b = 0; b < 2; ++b)
#pragma unroll
                for (int m = 0; m < 4; ++m)
#pragma unroll
                    for (int n = 0; n < 2; ++n) acc[a][b][m][n] = (f32x4){0.f, 0.f, 0.f, 0.f};
        cur = nxt; cA = nA; cB = nB; ++ui;
        if (wr == 1) PG8_BAR;
    }
    PG8_WAIT_V(0);
    PG8_BAR;
#undef PG8_SA
#undef PG8_SB
#undef PG8_STAGE
#undef PG8_LDA
#undef PG8_LDB
#undef PG8_MMA
#undef PG8_WAIT_V
#undef PG8_WAIT_L
#undef PG8_BAR
#undef PG8_SCHED
}

struct EpiBf16 {
    static constexpr bool PERM = true;
    bf16_t* O; int ldc; float scale;
    __device__ __forceinline__ void operator()(const f32x4 (&acc)[2][2][4][2], const Unit& u, int wr, int wc, int fr, int fq) const {
        const int row0 = u.pm * BM + wr * 64 + fr, col0 = u.pn * BM + wc * 32 + 8 * fq;
#pragma unroll
        for (int ai = 0; ai < 2; ++ai)
#pragma unroll
            for (int m = 0; m < 4; ++m) { bf16_t* rowp = O + (size_t)(row0 + ai * HALF + m * 16) * ldc + col0;
#pragma unroll
                for (int bj = 0; bj < 2; ++bj) { const f32x4 v0 = acc[ai][bj][m][0] * scale, v1 = acc[ai][bj][m][1] * scale;
                    u32x4 w; w.x = cvt_pk_bf16(v0[0], v0[1]); w.y = cvt_pk_bf16(v0[2], v0[3]); w.z = cvt_pk_bf16(v1[0], v1[1]); w.w = cvt_pk_bf16(v1[2], v1[3]);
                    *(u32x4*)(rowp + bj * HALF) = w; } }
    }
};
struct EpiH {
    static constexpr bool PERM = true;
    bf16_t* H; float* gates;
    __device__ __forceinline__ void operator()(const f32x4 (&acc)[2][2][4][2], const Unit& u, int wr, int wc, int fr, int fq) const {
        const int row0 = u.pm * BM + wr * 64 + fr;
        if (u.pn < 18) {
            const int col0 = u.pn * BM + wc * 32 + 8 * fq;
#pragma unroll
            for (int ai = 0; ai < 2; ++ai)
#pragma unroll
                for (int m = 0; m < 4; ++m) { bf16_t* rowp = H + (size_t)(row0 + ai * HALF + m * 16) * HP + col0;
#pragma unroll
                    for (int bj = 0; bj < 2; ++bj) { const f32x4 v0 = acc[ai][bj][m][0], v1 = acc[ai][bj][m][1];
                        u32x4 w; w.x = cvt_pk_bf16(v0[0], v0[1]); w.y = cvt_pk_bf16(v0[2], v0[3]); w.z = cvt_pk_bf16(v1[0], v1[1]); w.w = cvt_pk_bf16(v1[2], v1[3]);
                        *(u32x4*)(rowp + bj * HALF) = w; } }
        } else if (wc == 0 && fq < 2) {
#pragma unroll
            for (int ai = 0; ai < 2; ++ai)
#pragma unroll
                for (int m = 0; m < 4; ++m) { float* rowp = gates + (size_t)(row0 + ai * HALF + m * 16) * 16 + 8 * fq;
                    *(f32x4*)(rowp) = acc[ai][0][m][0]; *(f32x4*)(rowp + 4) = acc[ai][0][m][1]; }
        }
    }
};
__device__ __forceinline__ void ln_build_table(const f32x2* __restrict__ ST, int pm, int tid, LAS f32x2* tab) {
    const int rl = tid >> 1, hf = tid & 1; const f32x2* p = ST + (size_t)(pm * BM + rl) * 32 + 16 * hf; float s = 0.f, q = 0.f;
#pragma unroll
    for (int j = 0; j < 16; ++j) { const f32x2 v = p[j]; s += v[0]; q += v[1]; }
    s += __shfl_xor(s, 1); q += __shfl_xor(q, 1);
    const float mean = s * (1.0f / DM); const float var = fmaxf(q * (1.0f / DM) - mean * mean, 0.f);
    if (hf == 0) tab[rl] = (f32x2){mean, 1.0f / sqrtf(var + LN_EPS)};
}
template <class Sched> __device__ __forceinline__ int ln_build_tables(const f32x2* __restrict__ ST, const Sched& S, int tid, LAS f32x2* tab) {
    Unit u; int pm0 = -1;
    if (S.next(0, u)) { pm0 = u.pm; ln_build_table(ST, u.pm, tid, tab); if (S.next(1, u)) ln_build_table(ST, u.pm, tid, tab + 256); }
    LDS_WAIT(); __syncthreads();
    return pm0;
}
template <int MODE> struct EpiResStats {
    static constexpr bool PERM = true;
    const float* base; bf16_t* zb; f32x2* stn; LAS const f32x2* tab; int pm0; const float* gain; const float* bias; float alpha;
    __device__ __forceinline__ void operator()(const f32x4 (&acc)[2][2][4][2], const Unit& u, int wr, int wc, int fr, int fq) const {
        const int row0 = u.pm * BM + wr * 64 + fr, col0 = u.pn * BM + wc * 32 + 8 * fq;
        f32x4 gg[2][2], bb[2][2];
        if (MODE == 1) {
#pragma unroll
            for (int bj = 0; bj < 2; ++bj)
#pragma unroll
                for (int n = 0; n < 2; ++n) { gg[bj][n] = *(const f32x4*)(gain + col0 + bj * HALF + 4 * n); bb[bj][n] = *(const f32x4*)(bias + col0 + bj * HALF + 4 * n); } }
        u32x4 zin[3][2]; f32x4 xin[3][2][2];
#define ERS_LOAD(IT, SLOT) do { const int ai_ = (IT) >> 2, m_ = (IT) & 3; const size_t off_ = (size_t)(row0 + ai_ * HALF + m_ * 16) * DM + col0; \
            _Pragma("unroll") for (int bj = 0; bj < 2; ++bj) { if (MODE == 1) zin[SLOT][bj] = *(const u32x4*)(zb + off_ + bj * HALF); \
                else { xin[SLOT][bj][0] = *(const f32x4*)(base + off_ + bj * HALF); xin[SLOT][bj][1] = *(const f32x4*)(base + off_ + bj * HALF + 4); } } } while (0)
        ERS_LOAD(0, 0); ERS_LOAD(1, 1);
#pragma unroll
        for (int it = 0; it < 8; ++it) { const int ai = it >> 2, m = it & 3, sl = it % 3;
            if (it + 2 < 8) ERS_LOAD(it + 2, (it + 2) % 3);
            const int row = row0 + ai * HALF + m * 16; const size_t off = (size_t)row * DM + col0;
            f32x2 st = {0.f, 1.f}; if (MODE == 1) st = tab[(u.pm == pm0 ? 0 : 256) + ai * HALF + wr * 64 + m * 16 + fr];
            float s = 0.f, q = 0.f;
#pragma unroll
            for (int bj = 0; bj < 2; ++bj) { f32x4 o[2];
                if (MODE == 1) { const u32x4 zo = zin[sl][bj];
                    const f32x4 z0 = {bflo(zo[0]), bfhi(zo[0]), bflo(zo[1]), bfhi(zo[1])}, z1 = {bflo(zo[2]), bfhi(zo[2]), bflo(zo[3]), bfhi(zo[3])};
                    o[0] = ((z0 - st[0]) * st[1] * gg[bj][0] + bb[bj][0]) * alpha + acc[ai][bj][m][0]; o[1] = ((z1 - st[0]) * st[1] * gg[bj][1] + bb[bj][1]) * alpha + acc[ai][bj][m][1];
                } else {
                    o[0] = xin[sl][bj][0] * alpha + acc[ai][bj][m][0]; o[1] = xin[sl][bj][1] * alpha + acc[ai][bj][m][1]; }
#pragma unroll
                for (int n = 0; n < 2; ++n) { s += (o[n][0] + o[n][1]) + (o[n][2] + o[n][3]); q += (o[n][0] * o[n][0] + o[n][1] * o[n][1]) + (o[n][2] * o[n][2] + o[n][3] * o[n][3]); }
                u32x4 w; w.x = cvt_pk_bf16(o[0][0], o[0][1]); w.y = cvt_pk_bf16(o[0][2], o[0][3]); w.z = cvt_pk_bf16(o[1][0], o[1][1]); w.w = cvt_pk_bf16(o[1][2], o[1][3]);
                *(u32x4*)(zb + off + bj * HALF) = w; }
            s += __shfl_xor(s, 16); s += __shfl_xor(s, 32); q += __shfl_xor(q, 16); q += __shfl_xor(q, 32);
            if (fq == 0) stn[(size_t)row * 32 + 4 * u.pn + wc] = (f32x2){s, q}; }
#undef ERS_LOAD
    }
};
struct EpiLnFold {
    static constexpr bool PERM = true;
    bf16_t* O; int ldc; LAS const f32x2* tab; int pm0; const float* colsum; const float* bw;
    __device__ __forceinline__ void operator()(const f32x4 (&acc)[2][2][4][2], const Unit& u, int wr, int wc, int fr, int fq) const {
        const int row0 = u.pm * BM + wr * 64 + fr, col0 = u.pn * BM + wc * 32 + 8 * fq;
        f32x4 cs[2][2], bb[2][2];
#pragma unroll
        for (int bj = 0; bj < 2; ++bj)
#pragma unroll
            for (int n = 0; n < 2; ++n) { cs[bj][n] = *(const f32x4*)(colsum + col0 + bj * HALF + 4 * n); bb[bj][n] = *(const f32x4*)(bw + col0 + bj * HALF + 4 * n); }
#pragma unroll
        for (int ai = 0; ai < 2; ++ai)
#pragma unroll
            for (int m = 0; m < 4; ++m) { const int row = row0 + ai * HALF + m * 16; bf16_t* rowp = O + (size_t)row * ldc + col0; const f32x2 s = tab[(u.pm == pm0 ? 0 : 256) + ai * HALF + wr * 64 + m * 16 + fr];
#pragma unroll
                for (int bj = 0; bj < 2; ++bj) { const f32x4 v0 = (acc[ai][bj][m][0] - cs[bj][0] * s[0]) * s[1] + bb[bj][0], v1 = (acc[ai][bj][m][1] - cs[bj][1] * s[0]) * s[1] + bb[bj][1];
                    u32x4 w; w.x = cvt_pk_bf16(v0[0], v0[1]); w.y = cvt_pk_bf16(v0[2], v0[3]); w.z = cvt_pk_bf16(v1[0], v1[1]); w.w = cvt_pk_bf16(v1[2], v1[3]);
                    *(u32x4*)(rowp + bj * HALF) = w; } }
    }
};
struct EpiSoftmaxP {
    static constexpr bool PERM = true;
    bf16_t* P; int ldc; float scale; LAS float* tmax; LAS float* tsum;
    __device__ __forceinline__ void operator()(f32x4 (&acc)[2][2][4][2], const Unit& u, int wr, int wc, int fr, int fq) const {
        int fro = fr; asm volatile("" : "+v"(fro));
        const int row0 = u.pm * BM + wr * 64 + fro, col0 = u.pn * BM + wc * 32 + 8 * fq;
        float mx[2][4];
#pragma unroll
        for (int ai = 0; ai < 2; ++ai)
#pragma unroll
            for (int m = 0; m < 4; ++m) { float v = -__builtin_inff();
#pragma unroll
                for (int bj = 0; bj < 2; ++bj)
#pragma unroll
                    for (int n = 0; n < 2; ++n) { const f32x4 x = acc[ai][bj][m][n]; v = fmaxf(v, fmaxf(fmaxf(x[0], x[1]), fmaxf(x[2], x[3]))); }
                v = fmaxf(v, __shfl_xor(v, 16)); v = fmaxf(v, __shfl_xor(v, 32)); mx[ai][m] = v;
                if (fq == 0) tmax[(ai * HALF + wr * 64 + m * 16 + fro) * 4 + wc] = v; }
        LDS_WAIT(); __builtin_amdgcn_s_barrier(); asm volatile("" ::: "memory");
#pragma unroll
        for (int ai = 0; ai < 2; ++ai)
#pragma unroll
            for (int m = 0; m < 4; ++m) { const f32x4 pm4 = *(const LAS f32x4*)(tmax + (ai * HALF + wr * 64 + m * 16 + fro) * 4);
                const float rm = fmaxf(fmaxf(pm4[0], pm4[1]), fmaxf(pm4[2], pm4[3])) * scale; float s = 0.f;
#pragma unroll
                for (int bj = 0; bj < 2; ++bj)
#pragma unroll
                    for (int n = 0; n < 2; ++n) { f32x4 x = acc[ai][bj][m][n];
#pragma unroll
                        for (int j = 0; j < 4; ++j) { x[j] = __expf(x[j] * scale - rm); s += x[j]; }
                        acc[ai][bj][m][n] = x; }
                s += __shfl_xor(s, 16); s += __shfl_xor(s, 32);
                if (fq == 0) tsum[(ai * HALF + wr * 64 + m * 16 + fro) * 4 + wc] = s; }
        LDS_WAIT(); __builtin_amdgcn_s_barrier(); asm volatile("" ::: "memory");
#pragma unroll
        for (int ai = 0; ai < 2; ++ai)
#pragma unroll
            for (int m = 0; m < 4; ++m) { const f32x4 ps4 = *(const LAS f32x4*)(tsum + (ai * HALF + wr * 64 + m * 16 + fro) * 4);
                const float inv = 1.0f / ((ps4[0] + ps4[1]) + (ps4[2] + ps4[3])); bf16_t* rowp = P + (size_t)(row0 + ai * HALF + m * 16) * ldc + col0;
#pragma unroll
                for (int bj = 0; bj < 2; ++bj) { const f32x4 v0 = acc[ai][bj][m][0] * inv, v1 = acc[ai][bj][m][1] * inv;
                    u32x4 w; w.x = cvt_pk_bf16(v0[0], v0[1]); w.y = cvt_pk_bf16(v0[2], v0[3]); w.z = cvt_pk_bf16(v1[0], v1[1]); w.w = cvt_pk_bf16(v1[2], v1[3]);
                    *(u32x4*)(rowp + bj * HALF) = w; } }
    }
};
struct EpiLnSoftmaxP {
    static constexpr bool PERM = true;
    EpiSoftmaxP sm; LAS const f32x2* tab; const float* cs; const float* bw;
    __device__ __forceinline__ void operator()(f32x4 (&acc)[2][2][4][2], const Unit& u, int wr, int wc, int fr, int fq) const {
        int fro = fr; asm volatile("" : "+v"(fro));
        const int col0 = u.pn * BM + wc * 32 + 8 * fq;
#pragma unroll
        for (int bj = 0; bj < 2; ++bj)
#pragma unroll
            for (int n = 0; n < 2; ++n) { const f32x4 c4 = *(const f32x4*)(cs + col0 + bj * HALF + 4 * n), b4 = *(const f32x4*)(bw + col0 + bj * HALF + 4 * n);
#pragma unroll
                for (int ai = 0; ai < 2; ++ai)
#pragma unroll
                    for (int m = 0; m < 4; ++m) { const f32x2 st = tab[ai * HALF + wr * 64 + m * 16 + fro]; acc[ai][bj][m][n] = (acc[ai][bj][m][n] - c4 * st[0]) * st[1] + b4; } }
        sm(acc, u, wr, wc, fr, fq);
    }
};
struct BatchOrder : PlainOrder {
    size_t bstride;
    __device__ bool next(int i, Unit& u) const { if (!PlainOrder::next(i, u)) return false; u.b += (size_t)(u.pm >> 4) * bstride; return true; }
};
struct EpiF32 {
    static constexpr bool PERM = false;
    float* C; int ldc; float scale;
    __device__ __forceinline__ void operator()(const f32x4 (&acc)[2][2][4][2], const Unit& u, int wr, int wc, int fr, int fq) const {
        const int row0 = u.pm * BM + wr * 64 + fr, col0 = u.pn * BM + wc * 32 + 4 * fq;
#pragma unroll
        for (int ai = 0; ai < 2; ++ai)
#pragma unroll
            for (int m = 0; m < 4; ++m) { float* rowp = C + (size_t)(row0 + ai * HALF + m * 16) * ldc + col0;
#pragma unroll
                for (int bj = 0; bj < 2; ++bj)
#pragma unroll
                    for (int n = 0; n < 2; ++n) *(f32x4*)(rowp + bj * HALF + n * 16) = acc[ai][bj][m][n] * scale; }
    }
};
}

struct Ctx { LAS unsigned char* lds; int tid, lane, wave, vcu, G, gw, NGW, bx; };

__device__ __forceinline__ void p0_transpose_item(const float* W, int K, int N, bf16_t* WT, LAS float* scr, int item, int nblk, int lane,
                                                  const float* gvec = nullptr, const float* bvec = nullptr, float* colsum = nullptr, float* bw = nullptr, bf16_t* WN = nullptr) {
    const int kb = item / nblk, nb = item % nblk, k0 = 64 * kb, n0 = 32 * nb;
    const int nn = n0 + (lane & 31);
    float pcs = 0.f, pbw = 0.f; float wv[32];
#pragma unroll
    for (int i = 0; i < 32; ++i) { const int kk = 2 * i + (lane >> 5); wv[i] = (nn < N) ? W[(size_t)(k0 + kk) * N + nn] : 0.f; }
#pragma unroll
    for (int i = 0; i < 32; ++i) { const int kk = 2 * i + (lane >> 5); float w = wv[i];
        if (gvec) { pbw += w * bvec[k0 + kk]; w *= gvec[k0 + kk]; pcs += w; }
        scr[kk * 33 + (lane & 31)] = w; }
    if (gvec) { pcs += __shfl_xor(pcs, 32); pbw += __shfl_xor(pbw, 32); if (lane < 32) { colsum[(size_t)kb * 2048 + nn] = pcs; bw[(size_t)kb * 2048 + nn] = pbw; } }
    LDS_WAIT(); asm volatile("" ::: "memory");
    if (WN) {
        const LAS float* rp = scr + lane * 33;
#pragma unroll
        for (int q = 0; q < 4; ++q) { u32x4 o; o.x = pk2(rp[8 * q], rp[8 * q + 1]); o.y = pk2(rp[8 * q + 2], rp[8 * q + 3]); o.z = pk2(rp[8 * q + 4], rp[8 * q + 5]); o.w = pk2(rp[8 * q + 6], rp[8 * q + 7]);
            *(u32x4*)(WN + (size_t)(k0 + lane) * N + n0 + 8 * q) = o; }
        LDS_WAIT(); asm volatile("" ::: "memory");
        return; }
    const int c = lane & 7;
#pragma unroll
    for (int j = 0; j < 4; ++j) { const int n = (lane >> 3) + 8 * j; const LAS float* s = scr + (8 * c) * 33 + n;
        u32x4 o; o.x = pk2(s[0 * 33], s[1 * 33]); o.y = pk2(s[2 * 33], s[3 * 33]); o.z = pk2(s[4 * 33], s[5 * 33]); o.w = pk2(s[6 * 33], s[7 * 33]);
        *(u32x4*)(WT + (size_t)(n0 + n) * K + k0 + 8 * c) = o; }
    LDS_WAIT(); asm volatile("" ::: "memory");
}
__device__ __forceinline__ void p0_convert(const Ctx& C, const float* __restrict__ src, bf16_t* __restrict__ dst, long n8) {
    const long gt = (long)C.vcu * NTHREADS + C.tid, NGT = (long)C.G * NTHREADS;
    long i = gt;
    for (; i + 3 * NGT < n8; i += 4 * NGT) {
        f32x4 a[4], b[4];
#pragma unroll
        for (int u = 0; u < 4; ++u) { a[u] = *(const f32x4*)(src + (i + u * NGT) * 8); b[u] = *(const f32x4*)(src + (i + u * NGT) * 8 + 4); }
#pragma unroll
        for (int u = 0; u < 4; ++u) { u32x4 o; o.x = pk2(a[u][0], a[u][1]); o.y = pk2(a[u][2], a[u][3]); o.z = pk2(b[u][0], b[u][1]); o.w = pk2(b[u][2], b[u][3]); *(u32x4*)(dst + (i + u * NGT) * 8) = o; }
    }
    for (; i < n8; i += NGT) {
        const f32x4 a = *(const f32x4*)(src + i * 8), b = *(const f32x4*)(src + i * 8 + 4);
        u32x4 o; o.x = pk2(a[0], a[1]); o.y = pk2(a[2], a[3]); o.z = pk2(b[0], b[1]); o.w = pk2(b[2], b[3]);
        *(u32x4*)(dst + i * 8) = o;
    }
}

__device__ __forceinline__ void p0_convert_rowscale(const Ctx& C, const float* __restrict__ src, bf16_t* __restrict__ dst, const float* __restrict__ g, long n8) {
    const long gt = (long)C.vcu * NTHREADS + C.tid, NGT = (long)C.G * NTHREADS;
    for (long i = gt; i < n8; i += NGT) { const float sc = g[i >> 8];
        const f32x4 a = *(const f32x4*)(src + i * 8) * sc, b = *(const f32x4*)(src + i * 8 + 4) * sc;
        u32x4 o; o.x = pk2(a[0], a[1]); o.y = pk2(a[2], a[3]); o.z = pk2(b[0], b[1]); o.w = pk2(b[2], b[3]);
        *(u32x4*)(dst + i * 8) = o; }
}
__device__ __forceinline__ void pass_knormrope(const Ctx& C, bf16_t* H, const float* __restrict__ kn) {
    const int l = C.lane, p = l & 31, isc = l >> 5;
    const int d1 = isc * 64 + p, d2 = d1 + 32;
    const float invf = exp2f(-(float)p * (13.287712379549449f / 32.0f));
    const float gk1 = kn[d1], gk2 = kn[d2];
    for (int row = C.gw; row < NT; row += C.NGW) {
        const int t = row & (SEQ - 1); const float pos = (float)(isc ? (t & 63) : (t >> 6));
        const float ang = pos * invf; const float rev = ang * 0.15915494309189535f; const float fr = rev - floorf(rev);
        const float sn = __builtin_amdgcn_sinf(fr), cs = __builtin_amdgcn_cosf(fr);
        bf16_t* hr = H + (size_t)row * HP + C_AK;
        float z1[2], z2[2], ss[2];
#pragma unroll
        for (int hd = 0; hd < 2; ++hd) { z1[hd] = bf2f(hr[hd * 128 + d1]); z2[hd] = bf2f(hr[hd * 128 + d2]); ss[hd] = z1[hd] * z1[hd] + z2[hd] * z2[hd]; }
#pragma unroll
        for (int o = 1; o < 64; o <<= 1) { ss[0] += __shfl_xor(ss[0], o); ss[1] += __shfl_xor(ss[1], o); }
#pragma unroll
        for (int hd = 0; hd < 2; ++hd) { const float rstd = 1.0f / sqrtf(ss[hd] * (1.0f / 128.0f) + RMS_EPS);
            const float a = z1[hd] * rstd * gk1, b = z2[hd] * rstd * gk2;
            hr[hd * 128 + d1] = (bf16_t)f2bf(a * cs - b * sn); hr[hd * 128 + d2] = (bf16_t)f2bf(a * sn + b * cs); }
    }
}

__device__ __forceinline__ void pass_mlpost(const Ctx& C, const bf16_t* __restrict__ HF, const bf16_t* __restrict__ HBk, const bf16_t* __restrict__ H, const float* __restrict__ mlnorm, bf16_t* __restrict__ CC) {
    for (int row = C.gw; row < NT; row += C.NGW) {
        f32x4 v[4]; u32x2 mo[4]; float ss[4];
#pragma unroll
        for (int hh = 0; hh < 4; ++hh) { const int col = hh * 256 + C.lane * 4;
            { const u32x2 a = *(const u32x2*)(HF + (size_t)row * 1024 + col), b = *(const u32x2*)(HBk + (size_t)row * 1024 + col);
              v[hh] = (f32x4){bflo(a.x) + bflo(b.x), bfhi(a.x) + bfhi(b.x), bflo(a.y) + bflo(b.y), bfhi(a.y) + bfhi(b.y)}; }
            mo[hh] = *(const u32x2*)(H + (size_t)row * HP + C_MO + col);
            ss[hh] = v[hh][0] * v[hh][0] + v[hh][1] * v[hh][1] + v[hh][2] * v[hh][2] + v[hh][3] * v[hh][3]; }
#pragma unroll
        for (int o = 1; o < 64; o <<= 1) {
#pragma unroll
            for (int hh = 0; hh < 4; ++hh) ss[hh] += __shfl_xor(ss[hh], o); }
#pragma unroll
        for (int hh = 0; hh < 4; ++hh) { const int col = hh * 256 + C.lane * 4;
            const float rstd = 1.0f / sqrtf(ss[hh] * (1.0f / 256.0f) + RMS_EPS);
            const f32x4 g = *(const f32x4*)(mlnorm + col);
            const float m0 = bflo(mo[hh].x), m1 = bfhi(mo[hh].x), m2 = bflo(mo[hh].y), m3 = bfhi(mo[hh].y);
            const float o0 = v[hh][0] * rstd * g[0] / (1.0f + __expf(-m0)), o1 = v[hh][1] * rstd * g[1] / (1.0f + __expf(-m1));
            const float o2 = v[hh][2] * rstd * g[2] / (1.0f + __expf(-m2)), o3 = v[hh][3] * rstd * g[3] / (1.0f + __expf(-m3));
            u32x2 o; o.x = pk2(o0, o1); o.y = pk2(o2, o3);
            *(u32x2*)(CC + (size_t)row * DM + 1024 + col) = o; }
    }
}

__device__ __forceinline__ void pass_softmax(const Ctx& C, const float* __restrict__ SC, bf16_t* __restrict__ P) {
    for (int row = C.gw; row < NT; row += C.NGW) {
        const f32x4* sr = (const f32x4*)(SC + (size_t)row * 1024) + C.lane;
        u32x2* pr = (u32x2*)(P + (size_t)row * 1024) + C.lane;
        f32x4 v[4]; float mx[4], sm[4];
#pragma unroll
        for (int h = 0; h < 4; ++h) { v[h] = sr[64 * h]; mx[h] = fmaxf(fmaxf(v[h][0], v[h][1]), fmaxf(v[h][2], v[h][3])); }
#pragma unroll
        for (int o = 1; o < 64; o <<= 1) {
#pragma unroll
            for (int h = 0; h < 4; ++h) mx[h] = fmaxf(mx[h], __shfl_xor(mx[h], o)); }
#pragma unroll
        for (int h = 0; h < 4; ++h) { v[h][0] = __expf(v[h][0] - mx[h]); v[h][1] = __expf(v[h][1] - mx[h]); v[h][2] = __expf(v[h][2] - mx[h]); v[h][3] = __expf(v[h][3] - mx[h]); sm[h] = (v[h][0] + v[h][1]) + (v[h][2] + v[h][3]); }
#pragma unroll
        for (int o = 1; o < 64; o <<= 1) {
#pragma unroll
            for (int h = 0; h < 4; ++h) sm[h] += __shfl_xor(sm[h], o); }
#pragma unroll
        for (int h = 0; h < 4; ++h) { const float inv = 1.0f / sm[h]; u32x2 o; o.x = pk2(v[h][0] * inv, v[h][1] * inv); o.y = pk2(v[h][2] * inv, v[h][3] * inv); pr[64 * h] = o; }
    }
}

namespace attn {
constexpr int D = 128, NW = 8, QBLK = 32, KVBLK = 64;
constexpr float SCALE = 0.088388347648318440f;
constexpr float THR = 8.f;
constexpr int LDQ = HP, LDK = HP, LDO = DM;
constexpr size_t SHM_V = KVBLK * D * 2, SHM_K = KVBLK * D * 2, SHM_ATTN = 2 * SHM_V + 2 * SHM_K + NW * 64 * 4;
#define KSWZ(row, colB) ((row) * 256 + ((colB) ^ (((row) & 7) << 4)))
__device__ __forceinline__ unsigned cvtpk(float lo, float hi) { unsigned r; asm volatile("v_cvt_pk_bf16_f32 %0, %1, %2" : "=v"(r) : "v"(lo), "v"(hi)); return r; }
__device__ __forceinline__ void partialSM(f32x16& p0, f32x16& p1, float& m_reg, float& mn, float& alpha) {
  constexpr float C = SCALE * 1.4426950408889634f;
  float pmax = p0[0]; for (int r = 1; r < 16; ++r) pmax = fmaxf(pmax, p0[r]); for (int r = 0; r < 16; ++r) pmax = fmaxf(pmax, p1[r]);
  { auto rr = __builtin_amdgcn_permlane32_swap(__float_as_uint(pmax), __float_as_uint(pmax), false, false);
    pmax = fmaxf(__uint_as_float(rr[0]), __uint_as_float(rr[1])); }
  if (__builtin_expect(__all(pmax - m_reg <= THR / SCALE), 1)) { mn = m_reg; alpha = 1.f; }
  else { mn = fmaxf(m_reg, pmax); alpha = __builtin_amdgcn_exp2f((m_reg - mn) * C); m_reg = mn; }
  float mnC = -mn * C;
  for (int r = 0; r < 16; ++r) p0[r] = fmaf(p0[r], C, mnC); for (int r = 0; r < 16; ++r) p1[r] = fmaf(p1[r], C, mnC);
  for (int r = 0; r < 16; ++r) p0[r] = __builtin_amdgcn_exp2f(p0[r]);
}
__device__ __forceinline__ void finishSM(f32x16& p0, f32x16& p1, float alpha, float& l_reg, bf16x8& pa0, bf16x8& pa1, bf16x8& pa2, bf16x8& pa3) {
  for (int r = 0; r < 16; ++r) p1[r] = __builtin_amdgcn_exp2f(p1[r]);
  float ps = 0; for (int r = 0; r < 16; ++r) ps += p0[r]; for (int r = 0; r < 16; ++r) ps += p1[r];
  { auto rr = __builtin_amdgcn_permlane32_swap(__float_as_uint(ps), __float_as_uint(ps), false, false);
    ps = __uint_as_float(rr[0]) + __uint_as_float(rr[1]); }
  l_reg = l_reg * alpha + ps;
#define PK4(P, BASE, OUT) do { unsigned a0 = cvtpk(P[BASE + 0], P[BASE + 1]), a1 = cvtpk(P[BASE + 2], P[BASE + 3]);   \
    unsigned b0 = cvtpk(P[BASE + 4], P[BASE + 5]), b1 = cvtpk(P[BASE + 6], P[BASE + 7]);                              \
    auto r0 = __builtin_amdgcn_permlane32_swap(a0, b0, false, false); auto r1 = __builtin_amdgcn_permlane32_swap(a1, b1, false, false); \
    u32x4 w = {r0[0], r1[0], r0[1], r1[1]}; OUT = *reinterpret_cast<bf16x8*>(&w); } while (0)
  PK4(p0, 0, pa0); PK4(p0, 8, pa1); PK4(p1, 0, pa2); PK4(p1, 8, pa3);
#undef PK4
}
__device__ __forceinline__ void qkt(f32x16& p0, f32x16& p1, const bf16_t* Ks, const bf16x8* qr, int r32, int hi) {
  p0 = f32x16{}; p1 = f32x16{};
  for (int d0 = 0; d0 < 8; ++d0) { int cb = (d0 * 16 + hi * 8) * 2;
    bf16x8 b0 = *reinterpret_cast<const bf16x8*>((const char*)Ks + KSWZ(r32, cb));
    bf16x8 b1 = *reinterpret_cast<const bf16x8*>((const char*)Ks + KSWZ(32 + r32, cb));
    p0 = __builtin_amdgcn_mfma_f32_32x32x16_bf16(b0, qr[d0], p0, 0, 0, 0);
    p1 = __builtin_amdgcn_mfma_f32_32x32x16_bf16(b1, qr[d0], p1, 0, 0, 0); }
}
__device__ __forceinline__ int v_st(int k, int c) { const int kk = (k & ~0xC) | ((k & 4) << 1) | ((k & 8) >> 1); return ((kk >> 3) * 4 + (c >> 5)) * 512 + ((kk & 7) * 32 + (c & 31)) * 2; }
__device__ __forceinline__ int v_rd_base(int lane) { return ((lane & 3) << 3) | (((lane >> 2) & 3) << 6) | (((lane >> 4) & 1) << 5) | (((lane >> 5) & 1) << 8); }
constexpr int v_rd_off(int d0, int ks, int half) { return d0 * 512 + ks * 4096 + half * 2048; }
template <int OFF> __device__ __forceinline__ s16x4 tr_read(int vb) {
  s16x4 r; asm volatile("ds_read_b64_tr_b16 %0, %1 offset:%2" : "=&v"(r) : "v"(vb), "i"(OFF) : "memory"); return r;
}
template <int D0> __device__ __forceinline__ void pv_one(f32x16& od, int vb, bf16x8 pa0, bf16x8 pa1, bf16x8 pa2, bf16x8 pa3) {
  const s16x4 l0 = tr_read<v_rd_off(D0, 0, 0)>(vb), h0 = tr_read<v_rd_off(D0, 0, 1)>(vb), l1 = tr_read<v_rd_off(D0, 1, 0)>(vb), h1 = tr_read<v_rd_off(D0, 1, 1)>(vb);
  const s16x4 l2 = tr_read<v_rd_off(D0, 2, 0)>(vb), h2 = tr_read<v_rd_off(D0, 2, 1)>(vb), l3 = tr_read<v_rd_off(D0, 3, 0)>(vb), h3 = tr_read<v_rd_off(D0, 3, 1)>(vb);
  asm volatile("s_waitcnt lgkmcnt(0)" ::: "memory"); SBAR();
#define PK(L, H) (bf16x8){L[0], L[1], L[2], L[3], H[0], H[1], H[2], H[3]}
  od = __builtin_amdgcn_mfma_f32_32x32x16_bf16(pa0, PK(l0, h0), od, 0, 0, 0);
  od = __builtin_amdgcn_mfma_f32_32x32x16_bf16(pa1, PK(l1, h1), od, 0, 0, 0);
  od = __builtin_amdgcn_mfma_f32_32x32x16_bf16(pa2, PK(l2, h2), od, 0, 0, 0);
  od = __builtin_amdgcn_mfma_f32_32x32x16_bf16(pa3, PK(l3, h3), od, 0, 0, 0);
#undef PK
}
__device__ __forceinline__ void pv_d0(f32x16* o, int vb, bf16x8 pa0, bf16x8 pa1, bf16x8 pa2, bf16x8 pa3) {
  pv_one<0>(o[0], vb, pa0, pa1, pa2, pa3); pv_one<1>(o[1], vb, pa0, pa1, pa2, pa3); pv_one<2>(o[2], vb, pa0, pa1, pa2, pa3); pv_one<3>(o[3], vb, pa0, pa1, pa2, pa3);
}
__device__ __forceinline__ void q_norm_rope_frag(const bf16_t* __restrict__ Qw, const float* __restrict__ qgain, int hi, int tq, bf16x8 (&qr)[8]) {
    int hio = hi; asm volatile("" : "+v"(hio));
    float ss = 0.f;
#pragma unroll
    for (int d0 = 0; d0 < 8; ++d0) { qr[d0] = *reinterpret_cast<const bf16x8*>(Qw + d0 * 16);
#pragma unroll
      for (int j = 0; j < 8; ++j) { const float v = bf2f((unsigned short)qr[d0][j]); ss += v * v; } }
    { auto rr = __builtin_amdgcn_permlane32_swap(__float_as_uint(ss), __float_as_uint(ss), false, false); ss = __uint_as_float(rr[0]) + __uint_as_float(rr[1]); }
    const float rstd = 1.0f / sqrtf(ss * (1.0f / 128.0f) + RMS_EPS);
#pragma unroll
    for (int hf = 0; hf < 2; ++hf) {
      const float pos = (float)(hf ? (tq & 63) : (tq >> 6));
#pragma unroll
      for (int dq = 0; dq < 2; ++dq) { const int da = 4 * hf + dq, db = da + 2;
        const f32x4 ga0 = *(const f32x4*)(qgain + 16 * da + 8 * hio), ga1 = *(const f32x4*)(qgain + 16 * da + 8 * hio + 4), gb0 = *(const f32x4*)(qgain + 16 * db + 8 * hio), gb1 = *(const f32x4*)(qgain + 16 * db + 8 * hio + 4);
        float za[8], zb[8];
#pragma unroll
        for (int j = 0; j < 8; ++j) { const float ga = j < 4 ? ga0[j & 3] : ga1[j & 3], gb = j < 4 ? gb0[j & 3] : gb1[j & 3];
          const float z1 = bf2f((unsigned short)qr[da][j]) * rstd * ga, z2 = bf2f((unsigned short)qr[db][j]) * rstd * gb;
          const int p = 16 * dq + 8 * hio + j; const float invf = exp2f(-(float)p * (13.287712379549449f / 32.0f));
          const float rev = pos * invf * 0.15915494309189535f, fr = rev - floorf(rev); const float sn = __builtin_amdgcn_sinf(fr), cs = __builtin_amdgcn_cosf(fr);
          za[j] = z1 * cs - z2 * sn; zb[j] = z1 * sn + z2 * cs; }
        { u32x4 w = {cvt_pk_bf16(za[0], za[1]), cvt_pk_bf16(za[2], za[3]), cvt_pk_bf16(za[4], za[5]), cvt_pk_bf16(za[6], za[7])}; qr[da] = *reinterpret_cast<bf16x8*>(&w); }
        { u32x4 w = {cvt_pk_bf16(zb[0], zb[1]), cvt_pk_bf16(zb[2], zb[3]), cvt_pk_bf16(zb[4], zb[5]), cvt_pk_bf16(zb[6], zb[7])}; qr[db] = *reinterpret_cast<bf16x8*>(&w); }
        SBAR(); } }
}
__device__ __forceinline__ void attn_dense_body(const bf16_t* __restrict__ Qb, const bf16_t* __restrict__ Kh, const bf16_t* __restrict__ Vh, bf16_t* __restrict__ Ob, int seq, char* lds, int tid, int wid, const float* __restrict__ qgain, int t0) {
  const int lane = tid & 63, r32 = lane & 31, hi = lane >> 5;
  bf16_t* V_lds = (bf16_t*)lds; bf16_t* K_lds = (bf16_t*)(lds + 2 * SHM_V);
  float* ws = (float*)(lds + 2 * SHM_V + 2 * SHM_K) + wid * 64; float* li_l = ws; float* al_l = ws + 32;
  bf16x8 qr[8];
  const bf16_t* Qw = Qb + (long)(wid * QBLK + r32) * LDQ + hi * 8;
  q_norm_rope_frag(Qw, qgain, hi, t0 + wid * QBLK + r32, qr);
  float m_reg = -1e30f, l_reg = 0; f32x16 o[4] = {};
  const int sr = tid >> 4, sc = (tid & 15) * 8, vst0 = v_st(sr, sc), vst1 = v_st(32 + sr, sc);
  const int vb0 = (int)(uintptr_t)V_lds + v_rd_base(lane);
  struct { bf16x8 vs0, vs1, ks0, ks1; } sr_[2];
#define SLOAD(i, k0) do { sr_[i].vs0 = *reinterpret_cast<const bf16x8*>(&Vh[(long)((k0) + sr) * LDK + sc]); sr_[i].vs1 = *reinterpret_cast<const bf16x8*>(&Vh[(long)((k0) + 32 + sr) * LDK + sc]); \
    sr_[i].ks0 = *reinterpret_cast<const bf16x8*>(&Kh[(long)((k0) + sr) * LDK + sc]); sr_[i].ks1 = *reinterpret_cast<const bf16x8*>(&Kh[(long)((k0) + 32 + sr) * LDK + sc]); } while (0)
#define SWRITE(b, i) do { *(bf16x8*)((char*)V_lds + (b) * SHM_V + vst0) = sr_[i].vs0;          \
    *(bf16x8*)((char*)V_lds + (b) * SHM_V + vst1) = sr_[i].vs1; int kc = sc * 2;               \
    *(bf16x8*)((char*)K_lds + (b) * SHM_K + KSWZ(sr, kc)) = sr_[i].ks0;                       \
    *(bf16x8*)((char*)K_lds + (b) * SHM_K + KSWZ(32 + sr, kc)) = sr_[i].ks1; } while (0)
#define SWAIT() asm volatile("s_waitcnt vmcnt(4)" ::: "memory")
#define RESC(a) do { if (__any((a) < 1.f)) { if (hi == 0) al_l[r32] = (a); asm volatile("s_waitcnt lgkmcnt(0)" ::: "memory"); \
    for (int d = 0; d < 4; ++d) for (int r = 0; r < 16; ++r) o[d][r] *= al_l[crow(r, hi)]; } } while (0)
  f32x16 pA0, pA1, pB0, pB1; float mnA, mnB, alA, alB; bf16x8 pa0, pa1, pa2, pa3; const int NTL = seq / KVBLK;
  constexpr int SE = 0, SO = 1;
  SLOAD(SE, 0); asm volatile("s_waitcnt vmcnt(0)" ::: "memory"); SWRITE(0, SE); __syncthreads();
  qkt(pA0, pA1, K_lds, qr, r32, hi); partialSM(pA0, pA1, m_reg, mnA, alA);
  SLOAD(SO, KVBLK); if (2 < NTL) SLOAD(SE, 2 * KVBLK);
  SWAIT(); SWRITE(1, SO); __syncthreads();
  for (int j = 1; j + 1 < NTL; j += 2) {
    SBAR(); qkt(pB0, pB1, (bf16_t*)((char*)K_lds + SHM_K), qr, r32, hi);
    finishSM(pA0, pA1, alA, l_reg, pa0, pa1, pa2, pa3); SBAR();
    SLOAD(SO, (j + 2) * KVBLK); SBAR();
    pv_d0(o, vb0, pa0, pa1, pa2, pa3); partialSM(pB0, pB1, m_reg, mnB, alB);
    __syncthreads(); SWAIT(); SWRITE(0, SE);
    RESC(alB); __syncthreads();
    SBAR(); qkt(pA0, pA1, K_lds, qr, r32, hi);
    finishSM(pB0, pB1, alB, l_reg, pa0, pa1, pa2, pa3); SBAR();
    if (j + 3 < NTL) SLOAD(SE, (j + 3) * KVBLK); SBAR();
    pv_d0(o, vb0 + (int)SHM_V, pa0, pa1, pa2, pa3); partialSM(pA0, pA1, m_reg, mnA, alA);
    __syncthreads(); SWAIT(); SWRITE(1, SO);
    RESC(alA); __syncthreads();
  }
  SBAR(); qkt(pB0, pB1, (bf16_t*)((char*)K_lds + SHM_K), qr, r32, hi);
  finishSM(pA0, pA1, alA, l_reg, pa0, pa1, pa2, pa3); SBAR();
  pv_d0(o, vb0, pa0, pa1, pa2, pa3); partialSM(pB0, pB1, m_reg, mnB, alB);
  __syncthreads(); RESC(alB);
  finishSM(pB0, pB1, alB, l_reg, pa0, pa1, pa2, pa3); SBAR();
  pv_d0(o, vb0 + (int)SHM_V, pa0, pa1, pa2, pa3);
  if (hi == 0) li_l[r32] = l_reg; asm volatile("s_waitcnt lgkmcnt(0)" ::: "memory");
  float rli[16];
#pragma unroll
  for (int r = 0; r < 16; ++r) rli[r] = __builtin_amdgcn_rcpf(li_l[crow(r, hi)]);
  bf16_t* Ow = Ob + (long)(wid * QBLK) * LDO;
#pragma unroll
  for (int r = 0; r < 16; ++r) { int orow = crow(r, hi);
    for (int d0 = 0; d0 < 4; ++d0) Ow[(long)orow * LDO + d0 * 32 + r32] = (bf16_t)f2bf(o[d0][r] * rli[r]); }
#undef SLOAD
#undef SWRITE
#undef SWAIT
#undef RESC
}
#undef KSWZ
}

namespace mlstm {
constexpr int QP = 136, TP = 72, CP = 136, VP = 40;
constexpr int QSB = 64 * QP * 2, VSB = 64 * VP * 2, PSB = 64 * TP * 2, CTB = 32 * CP * 2;
constexpr int O_QS = 0, O_KS = O_QS + 2 * QSB, O_VS = O_KS + 2 * QSB, O_WV = O_VS + 3 * VSB, O_PS = O_WV + 2 * VSB, O_CT = O_PS + 2 * PSB;
constexpr int O_TAB = O_CT + 2 * CTB;
constexpr int O_GB = O_TAB + 4 * 384 * 4, O_NV = O_GB + 4 * 128 * 4, O_DEN = O_NV + 2 * 512, O_END = O_DEN + 2 * 256 * 4;
constexpr int O_HB = LDSCTL_OFF + 1024, HBB = 64 * VP * 2;
static_assert(O_HB + 2 * HBB <= LDS_BYTES && O_END <= LDSCTL_OFF && (O_VS % 16) == 0 && (O_WV % 16) == 0 && (O_PS % 16) == 0 && (O_CT % 16) == 0 && (O_TAB % 16) == 0 && (O_NV % 16) == 0, "mlstm LDS map");
constexpr float KSCALE = 0.08838834764831845f;
constexpr float LOG2E = 1.4426950408889634f, LOG2_KSCALE = -3.5f;

#define MFMA32(a, b, c) __builtin_amdgcn_mfma_f32_32x32x16_bf16(a, b, c, 0, 0, 0)
__device__ __forceinline__ s16x4 trrd(int addr) { s16x4 r; asm volatile("ds_read_b64_tr_b16 %0, %1" : "=v"(r) : "v"(addr) : "memory"); return r; }
#define TR_WAIT() asm volatile("s_waitcnt lgkmcnt(0)" ::: "memory")
#define PK8(L, H) (bf16x8){L[0], L[1], L[2], L[3], H[0], H[1], H[2], H[3]}
__device__ __forceinline__ float psum_halves(float v) { auto rr = __builtin_amdgcn_permlane32_swap(__float_as_uint(v), __float_as_uint(v), false, false); return __uint_as_float(rr[0]) + __uint_as_float(rr[1]); }

__device__ __forceinline__ void item(const Ctx& C, int it, const bf16_t* __restrict__ H, const float* __restrict__ gates, const float* __restrict__ b_ig, const float* __restrict__ b_fg, bf16_t* HF, bf16_t* HBk) {
    LAS unsigned char* lds = C.lds;
    const int tid = C.tid, lane = C.lane, wid = C.wave, r32 = lane & 31, hi = lane >> 5;
    const int seq = it >> 3, sl = it & 7, bb = seq >> 3, hh = (seq >> 1) & 3, dir = seq & 1;
    const size_t rowbase = (size_t)bb * SEQ;
    const bf16_t* qcol = H + C_MQ + hh * 128; const bf16_t* kcol = H + C_MK + hh * 128; const bf16_t* vcol = H + C_MV + hh * 256 + sl * 32;
    bf16_t* Hout = (dir ? HBk : HF) + hh * 256 + sl * 32;
    LAS float* tab = (LAS float*)(lds + O_TAB); LAS float* denp = (LAS float*)(lds + O_DEN);
#define TMAP(c, l) (dir ? (SEQ - 1 - (64 * (c) + (l))) : (64 * (c) + (l)))
    bf16x8 qreg[2], kreg[2], vreg = {};
    const int srow0 = tid & 31, sch = tid >> 5, vrow = tid & 63, vch = tid >> 6;
#define GLD16(dst, ptr) asm volatile("global_load_dwordx4 %0, %1, off" : "=v"(dst) : "v"(ptr) : "memory")
#define GLD4(dst, ptr) asm volatile("global_load_dword %0, %1, off" : "=v"(dst) : "v"(ptr) : "memory")
#define STAGE_LOAD(c) do { _Pragma("unroll") for (int i_ = 0; i_ < 2; ++i_) { const size_t gr_ = (rowbase + TMAP(c, srow0 + 32 * i_)) * HP + sch * 8; \
        GLD16(qreg[i_], qcol + gr_); GLD16(kreg[i_], kcol + gr_); } \
        if (tid < 256) GLD16(vreg, vcol + (rowbase + TMAP(c, vrow)) * HP + vch * 8); } while (0)
#define STAGE_WAIT() asm volatile("s_waitcnt vmcnt(0)" : "+v"(qreg[0]), "+v"(qreg[1]), "+v"(kreg[0]), "+v"(kreg[1]), "+v"(vreg), "+v"(g_i), "+v"(g_f) :: "memory")
#define STAGE_WRITE(c) do { const LAS float* tw_ = tab + ((c) & 3) * 384 + 256; \
        _Pragma("unroll") for (int i_ = 0; i_ < 2; ++i_) { const int l_ = srow0 + 32 * i_; \
            *(LAS bf16x8*)(lds + O_QS + ((c) & 1) * QSB + (l_ * QP + sch * 8) * 2) = qreg[i_]; *(LAS bf16x8*)(lds + O_KS + ((c) & 1) * QSB + (l_ * QP + sch * 8) * 2) = kreg[i_]; } \
        if (tid < 256) { const float w_ = tw_[vrow]; u32x4 wv_; \
            wv_.x = cvt_pk_bf16(bf2f((unsigned short)vreg[0]) * w_, bf2f((unsigned short)vreg[1]) * w_); wv_.y = cvt_pk_bf16(bf2f((unsigned short)vreg[2]) * w_, bf2f((unsigned short)vreg[3]) * w_); \
            wv_.z = cvt_pk_bf16(bf2f((unsigned short)vreg[4]) * w_, bf2f((unsigned short)vreg[5]) * w_); wv_.w = cvt_pk_bf16(bf2f((unsigned short)vreg[6]) * w_, bf2f((unsigned short)vreg[7]) * w_); \
            *(LAS bf16x8*)(lds + O_VS + ((c) % 3) * VSB + (vrow * VP + vch * 8) * 2) = vreg; *(LAS u32x4*)(lds + O_WV + ((c) & 1) * VSB + (vrow * VP + vch * 8) * 2) = wv_; } } while (0)
    float m_run = 0.f, g_i = 0.f, g_f = 0.f;
    const float big = b_ig[dir * 4 + hh], bfg = b_fg[dir * 4 + hh];
#define TLOAD(c) do { const size_t gr_ = (rowbase + TMAP(c, lane)) * 16; GLD4(g_i, gates + gr_ + dir * 4 + hh); GLD4(g_f, gates + gr_ + 8 + dir * 4 + hh); } while (0)
#define DPPMOV(idn, v, ctrl, rm) __builtin_bit_cast(float, __builtin_amdgcn_update_dpp(__builtin_bit_cast(int, (float)(idn)), __builtin_bit_cast(int, v), ctrl, rm, 0xf, false))
#define TCOMP(c) do { const float li_ = gbuf[((c) & 3) * 128 + lane] + big; const float gf_ = gbuf[((c) & 3) * 128 + 64 + lane] + bfg; \
        const float lf_ = fminf(gf_, 0.f) - __logf(1.0f + __expf(-fabsf(gf_))); \
        float b_ = lf_; b_ += DPPMOV(0.f, b_, 0x111, 0xf); b_ += DPPMOV(0.f, b_, 0x112, 0xf); b_ += DPPMOV(0.f, b_, 0x114, 0xf); b_ += DPPMOV(0.f, b_, 0x118, 0xf); \
        b_ += DPPMOV(0.f, b_, 0x142, 0xa); b_ += DPPMOV(0.f, b_, 0x143, 0xc); \
        const float blast_ = __builtin_bit_cast(float, __builtin_amdgcn_readlane(__builtin_bit_cast(int, b_), 63)); const float a_ = li_ - b_; \
        const float ninf_ = -__builtin_inff(); float pm_ = a_; \
        pm_ = fmaxf(pm_, DPPMOV(ninf_, pm_, 0x111, 0xf)); pm_ = fmaxf(pm_, DPPMOV(ninf_, pm_, 0x112, 0xf)); pm_ = fmaxf(pm_, DPPMOV(ninf_, pm_, 0x114, 0xf)); pm_ = fmaxf(pm_, DPPMOV(ninf_, pm_, 0x118, 0xf)); \
        pm_ = fmaxf(pm_, DPPMOV(ninf_, pm_, 0x142, 0xa)); pm_ = fmaxf(pm_, DPPMOV(ninf_, pm_, 0x143, 0xc)); \
        const float mm_ = fmaxf(m_run, pm_); const float amax_ = __builtin_bit_cast(float, __builtin_amdgcn_readlane(__builtin_bit_cast(int, pm_), 63)); \
        const float mnew_ = fmaxf(blast_ + m_run, blast_ + amax_); \
        LAS float* tb_ = tab + ((c) & 3) * 384; \
        tb_[lane] = -mm_ * LOG2E + LOG2_KSCALE; tb_[64 + lane] = a_ * LOG2E; tb_[128 + lane] = __expf(m_run - mm_); tb_[192 + lane] = __expf(-(b_ + mm_)); \
        tb_[256 + lane] = __expf(blast_ + a_ - mnew_) * KSCALE; if (lane == 0) tb_[320] = __expf(blast_ + m_run - mnew_); \
        m_run = mnew_; } while (0)

#define BAR() do { LDS_WAIT(); __builtin_amdgcn_s_barrier(); asm volatile("" ::: "memory"); } while (0)
    LAS float* gbuf = (LAS float*)(lds + O_GB);
#define GSAVE(c) do { gbuf[((c) & 3) * 128 + lane] = g_i; gbuf[((c) & 3) * 128 + 64 + lane] = g_f; } while (0)
    for (int i = tid; i < 2 * CTB / 4; i += NTHREADS) ((LAS unsigned*)(lds + O_CT))[i] = 0u;
    if (tid < 256) ((LAS unsigned*)(lds + O_NV))[tid] = 0u;
    denp[tid] = 0.f;
    if (wid == 5) { TLOAD(0); STAGE_WAIT(); GSAVE(0); TCOMP(0); TLOAD(1); STAGE_WAIT(); GSAVE(1); TCOMP(1); TLOAD(2); STAGE_WAIT(); GSAVE(2); TLOAD(3); }
    STAGE_LOAD(0);
    STAGE_WAIT();
    BAR();
    STAGE_WRITE(0);
    STAGE_LOAD(1);
    f32x16 cacc = {}, nacc = {};
    f32x16 acc2 = {}; float qnl = 0.f;
    BAR();
#define FINALIZE(cm) do { const LAS float* tbm = tab + ((cm) & 3) * 384; const int li = wid - 4; f32x16 acc3 = {}; const int nks = li ? 4 : 2; \
            const int l = 32 * li + r32; const float wi = tbm[128 + l]; const LAS float* dp = denp + ((cm) & 1) * 256; \
            const float den = (dp[l] + dp[64 + l]) + (dp[128 + l] + dp[192 + l]) + wi * qnl; const float enl = tbm[192 + l]; \
            bf16x8 pb[4]; \
            _Pragma("unroll") for (int t = 0; t < 4; ++t) if (t < nks) pb[t] = *(const LAS bf16x8*)(lds + O_PS + ((cm) & 1) * PSB + ((32 * li + r32) * TP + 16 * t + 8 * hi) * 2); \
            const int aV = (int)(uintptr_t)(lds + O_VS + ((cm) % 3) * VSB) + ((8 * hi + trq) * VP + 16 * trg + 4 * trp) * 2; \
            s16x4 vl[4], vh[4]; \
            _Pragma("unroll") for (int t = 0; t < 4; ++t) if (t < nks) { vl[t] = trrd(aV + 16 * t * VP * 2); vh[t] = trrd(aV + (16 * t + 4) * VP * 2); } \
            TR_WAIT(); \
            _Pragma("unroll") for (int t = 0; t < 4; ++t) if (t < nks) acc3 = MFMA32(PK8(vl[t], vh[t]), pb[t], acc3); \
            const float rinv = __builtin_amdgcn_rcpf(fmaxf(fabsf(den), enl)); \
            _Pragma("unroll") for (int g = 0; g < 4; ++g) { u32x2 hw; \
                hw.x = cvt_pk_bf16((acc3[4 * g] + wi * acc2[4 * g]) * rinv, (acc3[4 * g + 1] + wi * acc2[4 * g + 1]) * rinv); \
                hw.y = cvt_pk_bf16((acc3[4 * g + 2] + wi * acc2[4 * g + 2]) * rinv, (acc3[4 * g + 3] + wi * acc2[4 * g + 3]) * rinv); \
                *(LAS u32x2*)(lds + O_HB + ((cm) & 1) * HBB + (l * VP + 8 * g + 4 * hi) * 2) = hw; } } while (0)
#define HSTORE(cm) do { _Pragma("unroll") for (int u_ = 0; u_ < 2; ++u_) { const int p_ = (wid - 6) * 64 + lane + 128 * u_, row_ = p_ >> 2, q_ = p_ & 3; \
        const u32x4 hv_ = *(const LAS u32x4*)(lds + O_HB + ((cm) & 1) * HBB + row_ * VP * 2 + q_ * 16); \
        *(u32x4*)(Hout + (rowbase + TMAP(cm, row_)) * 1024 + q_ * 8) = hv_; } } while (0)
#define RESTAGE(c) do { STAGE_WAIT(); if ((c) + 1 < 64) { STAGE_WRITE((c) + 1); if ((c) + 2 < 64) STAGE_LOAD((c) + 2); } \
        if (wid == 5) { if ((c) + 3 < 64) GSAVE((c) + 3); if ((c) + 4 < 64) TLOAD((c) + 4); } } while (0)
    for (int c = 0; c < 64; ++c) {
        const LAS float* tb = tab + (c & 3) * 384;
        if (wid > 5 && c > 1) HSTORE(c - 2);
        if (wid < 4 || wid > 5) {
            int lo_ = lane; asm volatile("" : "+v"(lo_));
            const int r32 = lo_ & 31, hi = lo_ >> 5, trq = (lo_ & 15) >> 2, trp = lo_ & 3, trg = (lo_ >> 4) & 1;
            const int job = (wid < 4) ? wid : wid - 2, tile = (job >= 3) ? job - 3 : job, si = tile >> 1, li = (tile + 1) >> 1;
            f32x16 acc = {};
#pragma unroll
            for (int t = 0; t < 8; ++t) {
                const bf16x8 a = *(const LAS bf16x8*)(lds + O_KS + (c & 1) * QSB + ((32 * si + r32) * QP + 16 * t + 8 * hi) * 2);
                const bf16x8 b = *(const LAS bf16x8*)(lds + O_QS + (c & 1) * QSB + ((32 * li + r32) * QP + 16 * t + 8 * hi) * 2);
                acc = MFMA32(a, b, acc);
            }
            const int l = 32 * li + r32; const float g1l = tb[l];
#define S_HALF(P_) do { float ps = 0.f; \
            _Pragma("unroll") for (int g = 2 * (P_); g < 2 * (P_) + 2; ++g) { const f32x4 g2 = *(const LAS f32x4*)(tb + 64 + 32 * si + 8 * g + 4 * hi); float pv[4]; \
                _Pragma("unroll") for (int e = 0; e < 4; ++e) { const int s_ = 32 * si + 8 * g + 4 * hi + e; const float v = (s_ <= l) ? acc[4 * g + e] * __builtin_amdgcn_exp2f(g1l + g2[e]) : 0.f; pv[e] = v; ps += v; } \
                u32x2 w; w.x = cvt_pk_bf16(pv[0], pv[1]); w.y = cvt_pk_bf16(pv[2], pv[3]); \
                *(LAS u32x2*)(lds + O_PS + (c & 1) * PSB + (l * TP + 32 * si + 8 * g + 4 * hi) * 2) = w; } \
            ps = psum_halves(ps); if (hi == 0) denp[(c & 1) * 256 + (2 * si + (P_)) * 64 + l] = ps; } while (0)
            if (job < 3) S_HALF(0); else S_HALF(1);
#undef S_HALF
            if (wid < 4) {
                const float decay = tb[320];
                const int aK = (int)(uintptr_t)(lds + O_KS + (c & 1) * QSB) + ((8 * hi + trq) * QP + 32 * wid + 16 * trg + 4 * trp) * 2;
                const int aW = (int)(uintptr_t)(lds + O_WV + (c & 1) * VSB) + ((8 * hi + trq) * VP + 16 * trg + 4 * trp) * 2;
                s16x4 kl[4], kh[4], wl[4], wh[4];
#pragma unroll
                for (int t = 0; t < 4; ++t) { kl[t] = trrd(aK + 16 * t * QP * 2); kh[t] = trrd(aK + (16 * t + 4) * QP * 2); wl[t] = trrd(aW + 16 * t * VP * 2); wh[t] = trrd(aW + (16 * t + 4) * VP * 2); }
#pragma unroll
                for (int r = 0; r < 16; ++r) { cacc[r] *= decay; nacc[r] *= decay; }
                TR_WAIT();
#pragma unroll
                for (int t = 0; t < 4; ++t) {
                    const f32x4 w0 = *(const LAS f32x4*)(tb + 256 + 16 * t + 8 * hi), w1 = *(const LAS f32x4*)(tb + 256 + 16 * t + 8 * hi + 4);
                    u32x4 wb; wb.x = cvt_pk_bf16(w0[0], w0[1]); wb.y = cvt_pk_bf16(w0[2], w0[3]); wb.z = cvt_pk_bf16(w1[0], w1[1]); wb.w = cvt_pk_bf16(w1[2], w1[3]);
                    if (r32 != 0) wb = (u32x4){0u, 0u, 0u, 0u};
                    const bf16x8 a = PK8(kl[t], kh[t]);
                    cacc = MFMA32(a, PK8(wl[t], wh[t]), cacc);
                    nacc = MFMA32(a, __builtin_bit_cast(bf16x8, wb), nacc);
                }
#pragma unroll
                for (int g = 0; g < 4; ++g) { u32x2 w; w.x = cvt_pk_bf16(cacc[4 * g], cacc[4 * g + 1]); w.y = cvt_pk_bf16(cacc[4 * g + 2], cacc[4 * g + 3]);
                    *(LAS u32x2*)(lds + O_CT + (c & 1) * CTB + (r32 * CP + 32 * wid + 8 * g + 4 * hi) * 2) = w; }
                if (r32 == 0) {
#pragma unroll
                    for (int g = 0; g < 4; ++g) { u32x2 h2, l2; h2.x = cvt_pk_bf16(nacc[4 * g], nacc[4 * g + 1]); h2.y = cvt_pk_bf16(nacc[4 * g + 2], nacc[4 * g + 3]);
                        l2.x = cvt_pk_bf16(nacc[4 * g] - bflo(h2.x), nacc[4 * g + 1] - bfhi(h2.x)); l2.y = cvt_pk_bf16(nacc[4 * g + 2] - bflo(h2.y), nacc[4 * g + 3] - bfhi(h2.y));
                        *(LAS u32x2*)(lds + O_NV + (c & 1) * 512 + (32 * wid + 8 * g + 4 * hi) * 2) = h2; *(LAS u32x2*)(lds + O_NV + (c & 1) * 512 + 256 + (32 * wid + 8 * g + 4 * hi) * 2) = l2; } }
            }
        } else {
            int lo_ = lane; asm volatile("" : "+v"(lo_));
            const int r32 = lo_ & 31, hi = lo_ >> 5, trq = (lo_ & 15) >> 2, trp = lo_ & 3, trg = (lo_ >> 4) & 1;
            if (c > 0) FINALIZE(c - 1);
            const int li = wid - 4; f32x16 accq = {}; acc2 = (f32x16){};
#pragma unroll
            for (int t = 0; t < 8; ++t) {
                const bf16x8 a = *(const LAS bf16x8*)(lds + O_CT + ((c + 1) & 1) * CTB + (r32 * CP + 16 * t + 8 * hi) * 2);
                const bf16x8 b = *(const LAS bf16x8*)(lds + O_QS + (c & 1) * QSB + ((32 * li + r32) * QP + 16 * t + 8 * hi) * 2);
                acc2 = MFMA32(a, b, acc2);
                u32x4 na = *(const LAS u32x4*)(lds + O_NV + ((c + 1) & 1) * 512 + (r32 & 1) * 256 + (16 * t + 8 * hi) * 2);
                if (r32 & 0x1a) na = (u32x4){0u, 0u, 0u, 0u};
                accq = MFMA32(__builtin_bit_cast(bf16x8, na), b, accq);
            }
            qnl = accq[0] + accq[1];
            if (wid == 5 && c + 2 < 64) TCOMP(c + 2);
        }
        RESTAGE(c);
        BAR();
    }
    if (wid > 5) HSTORE(62);
    if (wid == 4 || wid == 5) { const int trq = (lane & 15) >> 2, trp = lane & 3, trg = (lane >> 4) & 1; FINALIZE(63); }
    BAR();
    if (wid > 5) HSTORE(63);
    BAR();
#undef FINALIZE
#undef HSTORE
#undef RESTAGE
    asm volatile("s_waitcnt vmcnt(0)" ::: "memory");
#undef BAR
#undef GSAVE
#undef GLD16
#undef GLD4
#undef STAGE_WAIT
#undef TMAP
#undef TR_WAIT
#undef PK8
#undef STAGE_LOAD
#undef STAGE_WRITE
#undef TLOAD
#undef TCOMP
#undef DPPMOV
}
#undef MFMA32
}
#define SORT16(A_, O_) do { { const unsigned h_ = A_[(O_) + 0] > A_[(O_) + 1] ? A_[(O_) + 0] : A_[(O_) + 1], l_ = A_[(O_) + 0] > A_[(O_) + 1] ? A_[(O_) + 1] : A_[(O_) + 0]; A_[(O_) + 0] = h_; A_[(O_) + 1] = l_; } { const unsigned h_ = A_[(O_) + 2] > A_[(O_) + 3] ? A_[(O_) + 2] : A_[(O_) + 3], l_ = A_[(O_) + 2] > A_[(O_) + 3] ? A_[(O_) + 3] : A_[(O_) + 2]; A_[(O_) + 2] = l_; A_[(O_) + 3] = h_; } { const unsigned h_ = A_[(O_) + 4] > A_[(O_) + 5] ? A_[(O_) + 4] : A_[(O_) + 5], l_ = A_[(O_) + 4] > A_[(O_) + 5] ? A_[(O_) + 5] : A_[(O_) + 4]; A_[(O_) + 4] = h_; A_[(O_) + 5] = l_; } { const unsigned h_ = A_[(O_) + 6] > A_[(O_) + 7] ? A_[(O_) + 6] : A_[(O_) + 7], l_ = A_[(O_) + 6] > A_[(O_) + 7] ? A_[(O_) + 7] : A_[(O_) + 6]; A_[(O_) + 6] = l_; A_[(O_) + 7] = h_; } { const unsigned h_ = A_[(O_) + 8] > A_[(O_) + 9] ? A_[(O_) + 8] : A_[(O_) + 9], l_ = A_[(O_) + 8] > A_[(O_) + 9] ? A_[(O_) + 9] : A_[(O_) + 8]; A_[(O_) + 8] = h_; A_[(O_) + 9] = l_; } { const unsigned h_ = A_[(O_) + 10] > A_[(O_) + 11] ? A_[(O_) + 10] : A_[(O_) + 11], l_ = A_[(O_) + 10] > A_[(O_) + 11] ? A_[(O_) + 11] : A_[(O_) + 10]; A_[(O_) + 10] = l_; A_[(O_) + 11] = h_; } { const unsigned h_ = A_[(O_) + 12] > A_[(O_) + 13] ? A_[(O_) + 12] : A_[(O_) + 13], l_ = A_[(O_) + 12] > A_[(O_) + 13] ? A_[(O_) + 13] : A_[(O_) + 12]; A_[(O_) + 12] = h_; A_[(O_) + 13] = l_; } { const unsigned h_ = A_[(O_) + 14] > A_[(O_) + 15] ? A_[(O_) + 14] : A_[(O_) + 15], l_ = A_[(O_) + 14] > A_[(O_) + 15] ? A_[(O_) + 15] : A_[(O_) + 14]; A_[(O_) + 14] = l_; A_[(O_) + 15] = h_; } { const unsigned h_ = A_[(O_) + 0] > A_[(O_) + 2] ? A_[(O_) + 0] : A_[(O_) + 2], l_ = A_[(O_) + 0] > A_[(O_) + 2] ? A_[(O_) + 2] : A_[(O_) + 0]; A_[(O_) + 0] = h_; A_[(O_) + 2] = l_; } { const unsigned h_ = A_[(O_) + 1] > A_[(O_) + 3] ? A_[(O_) + 1] : A_[(O_) + 3], l_ = A_[(O_) + 1] > A_[(O_) + 3] ? A_[(O_) + 3] : A_[(O_) + 1]; A_[(O_) + 1] = h_; A_[(O_) + 3] = l_; } { const unsigned h_ = A_[(O_) + 4] > A_[(O_) + 6] ? A_[(O_) + 4] : A_[(O_) + 6], l_ = A_[(O_) + 4] > A_[(O_) + 6] ? A_[(O_) + 6] : A_[(O_) + 4]; A_[(O_) + 4] = l_; A_[(O_) + 6] = h_; } { const unsigned h_ = A_[(O_) + 5] > A_[(O_) + 7] ? A_[(O_) + 5] : A_[(O_) + 7], l_ = A_[(O_) + 5] > A_[(O_) + 7] ? A_[(O_) + 7] : A_[(O_) + 5]; A_[(O_) + 5] = l_; A_[(O_) + 7] = h_; } { const unsigned h_ = A_[(O_) + 8] > A_[(O_) + 10] ? A_[(O_) + 8] : A_[(O_) + 10], l_ = A_[(O_) + 8] > A_[(O_) + 10] ? A_[(O_) + 10] : A_[(O_) + 8]; A_[(O_) + 8] = h_; A_[(O_) + 10] = l_; } { const unsigned h_ = A_[(O_) + 9] > A_[(O_) + 11] ? A_[(O_) + 9] : A_[(O_) + 11], l_ = A_[(O_) + 9] > A_[(O_) + 11] ? A_[(O_) + 11] : A_[(O_) + 9]; A_[(O_) + 9] = h_; A_[(O_) + 11] = l_; } { const unsigned h_ = A_[(O_) + 12] > A_[(O_) + 14] ? A_[(O_) + 12] : A_[(O_) + 14], l_ = A_[(O_) + 12] > A_[(O_) + 14] ? A_[(O_) + 14] : A_[(O_) + 12]; A_[(O_) + 12] = l_; A_[(O_) + 14] = h_; } { const unsigned h_ = A_[(O_) + 13] > A_[(O_) + 15] ? A_[(O_) + 13] : A_[(O_) + 15], l_ = A_[(O_) + 13] > A_[(O_) + 15] ? A_[(O_) + 15] : A_[(O_) + 13]; A_[(O_) + 13] = l_; A_[(O_) + 15] = h_; } { const unsigned h_ = A_[(O_) + 0] > A_[(O_) + 1] ? A_[(O_) + 0] : A_[(O_) + 1], l_ = A_[(O_) + 0] > A_[(O_) + 1] ? A_[(O_) + 1] : A_[(O_) + 0]; A_[(O_) + 0] = h_; A_[(O_) + 1] = l_; } { const unsigned h_ = A_[(O_) + 2] > A_[(O_) + 3] ? A_[(O_) + 2] : A_[(O_) + 3], l_ = A_[(O_) + 2] > A_[(O_) + 3] ? A_[(O_) + 3] : A_[(O_) + 2]; A_[(O_) + 2] = h_; A_[(O_) + 3] = l_; } { const unsigned h_ = A_[(O_) + 4] > A_[(O_) + 5] ? A_[(O_) + 4] : A_[(O_) + 5], l_ = A_[(O_) + 4] > A_[(O_) + 5] ? A_[(O_) + 5] : A_[(O_) + 4]; A_[(O_) + 4] = l_; A_[(O_) + 5] = h_; } { const unsigned h_ = A_[(O_) + 6] > A_[(O_) + 7] ? A_[(O_) + 6] : A_[(O_) + 7], l_ = A_[(O_) + 6] > A_[(O_) + 7] ? A_[(O_) + 7] : A_[(O_) + 6]; A_[(O_) + 6] = l_; A_[(O_) + 7] = h_; } { const unsigned h_ = A_[(O_) + 8] > A_[(O_) + 9] ? A_[(O_) + 8] : A_[(O_) + 9], l_ = A_[(O_) + 8] > A_[(O_) + 9] ? A_[(O_) + 9] : A_[(O_) + 8]; A_[(O_) + 8] = h_; A_[(O_) + 9] = l_; } { const unsigned h_ = A_[(O_) + 10] > A_[(O_) + 11] ? A_[(O_) + 10] : A_[(O_) + 11], l_ = A_[(O_) + 10] > A_[(O_) + 11] ? A_[(O_) + 11] : A_[(O_) + 10]; A_[(O_) + 10] = h_; A_[(O_) + 11] = l_; } { const unsigned h_ = A_[(O_) + 12] > A_[(O_) + 13] ? A_[(O_) + 12] : A_[(O_) + 13], l_ = A_[(O_) + 12] > A_[(O_) + 13] ? A_[(O_) + 13] : A_[(O_) + 12]; A_[(O_) + 12] = l_; A_[(O_) + 13] = h_; } { const unsigned h_ = A_[(O_) + 14] > A_[(O_) + 15] ? A_[(O_) + 14] : A_[(O_) + 15], l_ = A_[(O_) + 14] > A_[(O_) + 15] ? A_[(O_) + 15] : A_[(O_) + 14]; A_[(O_) + 14] = l_; A_[(O_) + 15] = h_; } { const unsigned h_ = A_[(O_) + 0] > A_[(O_) + 4] ? A_[(O_) + 0] : A_[(O_) + 4], l_ = A_[(O_) + 0] > A_[(O_) + 4] ? A_[(O_) + 4] : A_[(O_) + 0]; A_[(O_) + 0] = h_; A_[(O_) + 4] = l_; } { const unsigned h_ = A_[(O_) + 1] > A_[(O_) + 5] ? A_[(O_) + 1] : A_[(O_) + 5], l_ = A_[(O_) + 1] > A_[(O_) + 5] ? A_[(O_) + 5] : A_[(O_) + 1]; A_[(O_) + 1] = h_; A_[(O_) + 5] = l_; } { const unsigned h_ = A_[(O_) + 2] > A_[(O_) + 6] ? A_[(O_) + 2] : A_[(O_) + 6], l_ = A_[(O_) + 2] > A_[(O_) + 6] ? A_[(O_) + 6] : A_[(O_) + 2]; A_[(O_) + 2] = h_; A_[(O_) + 6] = l_; } { const unsigned h_ = A_[(O_) + 3] > A_[(O_) + 7] ? A_[(O_) + 3] : A_[(O_) + 7], l_ = A_[(O_) + 3] > A_[(O_) + 7] ? A_[(O_) + 7] : A_[(O_) + 3]; A_[(O_) + 3] = h_; A_[(O_) + 7] = l_; } { const unsigned h_ = A_[(O_) + 8] > A_[(O_) + 12] ? A_[(O_) + 8] : A_[(O_) + 12], l_ = A_[(O_) + 8] > A_[(O_) + 12] ? A_[(O_) + 12] : A_[(O_) + 8]; A_[(O_) + 8] = l_; A_[(O_) + 12] = h_; } { const unsigned h_ = A_[(O_) + 9] > A_[(O_) + 13] ? A_[(O_) + 9] : A_[(O_) + 13], l_ = A_[(O_) + 9] > A_[(O_) + 13] ? A_[(O_) + 13] : A_[(O_) + 9]; A_[(O_) + 9] = l_; A_[(O_) + 13] = h_; } { const unsigned h_ = A_[(O_) + 10] > A_[(O_) + 14] ? A_[(O_) + 10] : A_[(O_) + 14], l_ = A_[(O_) + 10] > A_[(O_) + 14] ? A_[(O_) + 14] : A_[(O_) + 10]; A_[(O_) + 10] = l_; A_[(O_) + 14] = h_; } { const unsigned h_ = A_[(O_) + 11] > A_[(O_) + 15] ? A_[(O_) + 11] : A_[(O_) + 15], l_ = A_[(O_) + 11] > A_[(O_) + 15] ? A_[(O_) + 15] : A_[(O_) + 11]; A_[(O_) + 11] = l_; A_[(O_) + 15] = h_; } { const unsigned h_ = A_[(O_) + 0] > A_[(O_) + 2] ? A_[(O_) + 0] : A_[(O_) + 2], l_ = A_[(O_) + 0] > A_[(O_) + 2] ? A_[(O_) + 2] : A_[(O_) + 0]; A_[(O_) + 0] = h_; A_[(O_) + 2] = l_; } { const unsigned h_ = A_[(O_) + 1] > A_[(O_) + 3] ? A_[(O_) + 1] : A_[(O_) + 3], l_ = A_[(O_) + 1] > A_[(O_) + 3] ? A_[(O_) + 3] : A_[(O_) + 1]; A_[(O_) + 1] = h_; A_[(O_) + 3] = l_; } { const unsigned h_ = A_[(O_) + 4] > A_[(O_) + 6] ? A_[(O_) + 4] : A_[(O_) + 6], l_ = A_[(O_) + 4] > A_[(O_) + 6] ? A_[(O_) + 6] : A_[(O_) + 4]; A_[(O_) + 4] = h_; A_[(O_) + 6] = l_; } { const unsigned h_ = A_[(O_) + 5] > A_[(O_) + 7] ? A_[(O_) + 5] : A_[(O_) + 7], l_ = A_[(O_) + 5] > A_[(O_) + 7] ? A_[(O_) + 7] : A_[(O_) + 5]; A_[(O_) + 5] = h_; A_[(O_) + 7] = l_; } { const unsigned h_ = A_[(O_) + 8] > A_[(O_) + 10] ? A_[(O_) + 8] : A_[(O_) + 10], l_ = A_[(O_) + 8] > A_[(O_) + 10] ? A_[(O_) + 10] : A_[(O_) + 8]; A_[(O_) + 8] = l_; A_[(O_) + 10] = h_; } { const unsigned h_ = A_[(O_) + 9] > A_[(O_) + 11] ? A_[(O_) + 9] : A_[(O_) + 11], l_ = A_[(O_) + 9] > A_[(O_) + 11] ? A_[(O_) + 11] : A_[(O_) + 9]; A_[(O_) + 9] = l_; A_[(O_) + 11] = h_; } { const unsigned h_ = A_[(O_) + 12] > A_[(O_) + 14] ? A_[(O_) + 12] : A_[(O_) + 14], l_ = A_[(O_) + 12] > A_[(O_) + 14] ? A_[(O_) + 14] : A_[(O_) + 12]; A_[(O_) + 12] = l_; A_[(O_) + 14] = h_; } { const unsigned h_ = A_[(O_) + 13] > A_[(O_) + 15] ? A_[(O_) + 13] : A_[(O_) + 15], l_ = A_[(O_) + 13] > A_[(O_) + 15] ? A_[(O_) + 15] : A_[(O_) + 13]; A_[(O_) + 13] = l_; A_[(O_) + 15] = h_; } { const unsigned h_ = A_[(O_) + 0] > A_[(O_) + 1] ? A_[(O_) + 0] : A_[(O_) + 1], l_ = A_[(O_) + 0] > A_[(O_) + 1] ? A_[(O_) + 1] : A_[(O_) + 0]; A_[(O_) + 0] = h_; A_[(O_) + 1] = l_; } { const unsigned h_ = A_[(O_) + 2] > A_[(O_) + 3] ? A_[(O_) + 2] : A_[(O_) + 3], l_ = A_[(O_) + 2] > A_[(O_) + 3] ? A_[(O_) + 3] : A_[(O_) + 2]; A_[(O_) + 2] = h_; A_[(O_) + 3] = l_; } { const unsigned h_ = A_[(O_) + 4] > A_[(O_) + 5] ? A_[(O_) + 4] : A_[(O_) + 5], l_ = A_[(O_) + 4] > A_[(O_) + 5] ? A_[(O_) + 5] : A_[(O_) + 4]; A_[(O_) + 4] = h_; A_[(O_) + 5] = l_; } { const unsigned h_ = A_[(O_) + 6] > A_[(O_) + 7] ? A_[(O_) + 6] : A_[(O_) + 7], l_ = A_[(O_) + 6] > A_[(O_) + 7] ? A_[(O_) + 7] : A_[(O_) + 6]; A_[(O_) + 6] = h_; A_[(O_) + 7] = l_; } { const unsigned h_ = A_[(O_) + 8] > A_[(O_) + 9] ? A_[(O_) + 8] : A_[(O_) + 9], l_ = A_[(O_) + 8] > A_[(O_) + 9] ? A_[(O_) + 9] : A_[(O_) + 8]; A_[(O_) + 8] = l_; A_[(O_) + 9] = h_; } { const unsigned h_ = A_[(O_) + 10] > A_[(O_) + 11] ? A_[(O_) + 10] : A_[(O_) + 11], l_ = A_[(O_) + 10] > A_[(O_) + 11] ? A_[(O_) + 11] : A_[(O_) + 10]; A_[(O_) + 10] = l_; A_[(O_) + 11] = h_; } { const unsigned h_ = A_[(O_) + 12] > A_[(O_) + 13] ? A_[(O_) + 12] : A_[(O_) + 13], l_ = A_[(O_) + 12] > A_[(O_) + 13] ? A_[(O_) + 13] : A_[(O_) + 12]; A_[(O_) + 12] = l_; A_[(O_) + 13] = h_; } { const unsigned h_ = A_[(O_) + 14] > A_[(O_) + 15] ? A_[(O_) + 14] : A_[(O_) + 15], l_ = A_[(O_) + 14] > A_[(O_) + 15] ? A_[(O_) + 15] : A_[(O_) + 14]; A_[(O_) + 14] = l_; A_[(O_) + 15] = h_; } { const unsigned h_ = A_[(O_) + 0] > A_[(O_) + 8] ? A_[(O_) + 0] : A_[(O_) + 8], l_ = A_[(O_) + 0] > A_[(O_) + 8] ? A_[(O_) + 8] : A_[(O_) + 0]; A_[(O_) + 0] = h_; A_[(O_) + 8] = l_; } { const unsigned h_ = A_[(O_) + 1] > A_[(O_) + 9] ? A_[(O_) + 1] : A_[(O_) + 9], l_ = A_[(O_) + 1] > A_[(O_) + 9] ? A_[(O_) + 9] : A_[(O_) + 1]; A_[(O_) + 1] = h_; A_[(O_) + 9] = l_; } { const unsigned h_ = A_[(O_) + 2] > A_[(O_) + 10] ? A_[(O_) + 2] : A_[(O_) + 10], l_ = A_[(O_) + 2] > A_[(O_) + 10] ? A_[(O_) + 10] : A_[(O_) + 2]; A_[(O_) + 2] = h_; A_[(O_) + 10] = l_; } { const unsigned h_ = A_[(O_) + 3] > A_[(O_) + 11] ? A_[(O_) + 3] : A_[(O_) + 11], l_ = A_[(O_) + 3] > A_[(O_) + 11] ? A_[(O_) + 11] : A_[(O_) + 3]; A_[(O_) + 3] = h_; A_[(O_) + 11] = l_; } { const unsigned h_ = A_[(O_) + 4] > A_[(O_) + 12] ? A_[(O_) + 4] : A_[(O_) + 12], l_ = A_[(O_) + 4] > A_[(O_) + 12] ? A_[(O_) + 12] : A_[(O_) + 4]; A_[(O_) + 4] = h_; A_[(O_) + 12] = l_; } { const unsigned h_ = A_[(O_) + 5] > A_[(O_) + 13] ? A_[(O_) + 5] : A_[(O_) + 13], l_ = A_[(O_) + 5] > A_[(O_) + 13] ? A_[(O_) + 13] : A_[(O_) + 5]; A_[(O_) + 5] = h_; A_[(O_) + 13] = l_; } { const unsigned h_ = A_[(O_) + 6] > A_[(O_) + 14] ? A_[(O_) + 6] : A_[(O_) + 14], l_ = A_[(O_) + 6] > A_[(O_) + 14] ? A_[(O_) + 14] : A_[(O_) + 6]; A_[(O_) + 6] = h_; A_[(O_) + 14] = l_; } { const unsigned h_ = A_[(O_) + 7] > A_[(O_) + 15] ? A_[(O_) + 7] : A_[(O_) + 15], l_ = A_[(O_) + 7] > A_[(O_) + 15] ? A_[(O_) + 15] : A_[(O_) + 7]; A_[(O_) + 7] = h_; A_[(O_) + 15] = l_; } { const unsigned h_ = A_[(O_) + 0] > A_[(O_) + 4] ? A_[(O_) + 0] : A_[(O_) + 4], l_ = A_[(O_) + 0] > A_[(O_) + 4] ? A_[(O_) + 4] : A_[(O_) + 0]; A_[(O_) + 0] = h_; A_[(O_) + 4] = l_; } { const unsigned h_ = A_[(O_) + 1] > A_[(O_) + 5] ? A_[(O_) + 1] : A_[(O_) + 5], l_ = A_[(O_) + 1] > A_[(O_) + 5] ? A_[(O_) + 5] : A_[(O_) + 1]; A_[(O_) + 1] = h_; A_[(O_) + 5] = l_; } { const unsigned h_ = A_[(O_) + 2] > A_[(O_) + 6] ? A_[(O_) + 2] : A_[(O_) + 6], l_ = A_[(O_) + 2] > A_[(O_) + 6] ? A_[(O_) + 6] : A_[(O_) + 2]; A_[(O_) + 2] = h_; A_[(O_) + 6] = l_; } { const unsigned h_ = A_[(O_) + 3] > A_[(O_) + 7] ? A_[(O_) + 3] : A_[(O_) + 7], l_ = A_[(O_) + 3] > A_[(O_) + 7] ? A_[(O_) + 7] : A_[(O_) + 3]; A_[(O_) + 3] = h_; A_[(O_) + 7] = l_; } { const unsigned h_ = A_[(O_) + 8] > A_[(O_) + 12] ? A_[(O_) + 8] : A_[(O_) + 12], l_ = A_[(O_) + 8] > A_[(O_) + 12] ? A_[(O_) + 12] : A_[(O_) + 8]; A_[(O_) + 8] = h_; A_[(O_) + 12] = l_; } { const unsigned h_ = A_[(O_) + 9] > A_[(O_) + 13] ? A_[(O_) + 9] : A_[(O_) + 13], l_ = A_[(O_) + 9] > A_[(O_) + 13] ? A_[(O_) + 13] : A_[(O_) + 9]; A_[(O_) + 9] = h_; A_[(O_) + 13] = l_; } { const unsigned h_ = A_[(O_) + 10] > A_[(O_) + 14] ? A_[(O_) + 10] : A_[(O_) + 14], l_ = A_[(O_) + 10] > A_[(O_) + 14] ? A_[(O_) + 14] : A_[(O_) + 10]; A_[(O_) + 10] = h_; A_[(O_) + 14] = l_; } { const unsigned h_ = A_[(O_) + 11] > A_[(O_) + 15] ? A_[(O_) + 11] : A_[(O_) + 15], l_ = A_[(O_) + 11] > A_[(O_) + 15] ? A_[(O_) + 15] : A_[(O_) + 11]; A_[(O_) + 11] = h_; A_[(O_) + 15] = l_; } { const unsigned h_ = A_[(O_) + 0] > A_[(O_) + 2] ? A_[(O_) + 0] : A_[(O_) + 2], l_ = A_[(O_) + 0] > A_[(O_) + 2] ? A_[(O_) + 2] : A_[(O_) + 0]; A_[(O_) + 0] = h_; A_[(O_) + 2] = l_; } { const unsigned h_ = A_[(O_) + 1] > A_[(O_) + 3] ? A_[(O_) + 1] : A_[(O_) + 3], l_ = A_[(O_) + 1] > A_[(O_) + 3] ? A_[(O_) + 3] : A_[(O_) + 1]; A_[(O_) + 1] = h_; A_[(O_) + 3] = l_; } { const unsigned h_ = A_[(O_) + 4] > A_[(O_) + 6] ? A_[(O_) + 4] : A_[(O_) + 6], l_ = A_[(O_) + 4] > A_[(O_) + 6] ? A_[(O_) + 6] : A_[(O_) + 4]; A_[(O_) + 4] = h_; A_[(O_) + 6] = l_; } { const unsigned h_ = A_[(O_) + 5] > A_[(O_) + 7] ? A_[(O_) + 5] : A_[(O_) + 7], l_ = A_[(O_) + 5] > A_[(O_) + 7] ? A_[(O_) + 7] : A_[(O_) + 5]; A_[(O_) + 5] = h_; A_[(O_) + 7] = l_; } { const unsigned h_ = A_[(O_) + 8] > A_[(O_) + 10] ? A_[(O_) + 8] : A_[(O_) + 10], l_ = A_[(O_) + 8] > A_[(O_) + 10] ? A_[(O_) + 10] : A_[(O_) + 8]; A_[(O_) + 8] = h_; A_[(O_) + 10] = l_; } { const unsigned h_ = A_[(O_) + 9] > A_[(O_) + 11] ? A_[(O_) + 9] : A_[(O_) + 11], l_ = A_[(O_) + 9] > A_[(O_) + 11] ? A_[(O_) + 11] : A_[(O_) + 9]; A_[(O_) + 9] = h_; A_[(O_) + 11] = l_; } { const unsigned h_ = A_[(O_) + 12] > A_[(O_) + 14] ? A_[(O_) + 12] : A_[(O_) + 14], l_ = A_[(O_) + 12] > A_[(O_) + 14] ? A_[(O_) + 14] : A_[(O_) + 12]; A_[(O_) + 12] = h_; A_[(O_) + 14] = l_; } { const unsigned h_ = A_[(O_) + 13] > A_[(O_) + 15] ? A_[(O_) + 13] : A_[(O_) + 15], l_ = A_[(O_) + 13] > A_[(O_) + 15] ? A_[(O_) + 15] : A_[(O_) + 13]; A_[(O_) + 13] = h_; A_[(O_) + 15] = l_; } { const unsigned h_ = A_[(O_) + 0] > A_[(O_) + 1] ? A_[(O_) + 0] : A_[(O_) + 1], l_ = A_[(O_) + 0] > A_[(O_) + 1] ? A_[(O_) + 1] : A_[(O_) + 0]; A_[(O_) + 0] = h_; A_[(O_) + 1] = l_; } { const unsigned h_ = A_[(O_) + 2] > A_[(O_) + 3] ? A_[(O_) + 2] : A_[(O_) + 3], l_ = A_[(O_) + 2] > A_[(O_) + 3] ? A_[(O_) + 3] : A_[(O_) + 2]; A_[(O_) + 2] = h_; A_[(O_) + 3] = l_; } { const unsigned h_ = A_[(O_) + 4] > A_[(O_) + 5] ? A_[(O_) + 4] : A_[(O_) + 5], l_ = A_[(O_) + 4] > A_[(O_) + 5] ? A_[(O_) + 5] : A_[(O_) + 4]; A_[(O_) + 4] = h_; A_[(O_) + 5] = l_; } { const unsigned h_ = A_[(O_) + 6] > A_[(O_) + 7] ? A_[(O_) + 6] : A_[(O_) + 7], l_ = A_[(O_) + 6] > A_[(O_) + 7] ? A_[(O_) + 7] : A_[(O_) + 6]; A_[(O_) + 6] = h_; A_[(O_) + 7] = l_; } { const unsigned h_ = A_[(O_) + 8] > A_[(O_) + 9] ? A_[(O_) + 8] : A_[(O_) + 9], l_ = A_[(O_) + 8] > A_[(O_) + 9] ? A_[(O_) + 9] : A_[(O_) + 8]; A_[(O_) + 8] = h_; A_[(O_) + 9] = l_; } { const unsigned h_ = A_[(O_) + 10] > A_[(O_) + 11] ? A_[(O_) + 10] : A_[(O_) + 11], l_ = A_[(O_) + 10] > A_[(O_) + 11] ? A_[(O_) + 11] : A_[(O_) + 10]; A_[(O_) + 10] = h_; A_[(O_) + 11] = l_; } { const unsigned h_ = A_[(O_) + 12] > A_[(O_) + 13] ? A_[(O_) + 12] : A_[(O_) + 13], l_ = A_[(O_) + 12] > A_[(O_) + 13] ? A_[(O_) + 13] : A_[(O_) + 12]; A_[(O_) + 12] = h_; A_[(O_) + 13] = l_; } { const unsigned h_ = A_[(O_) + 14] > A_[(O_) + 15] ? A_[(O_) + 14] : A_[(O_) + 15], l_ = A_[(O_) + 14] > A_[(O_) + 15] ? A_[(O_) + 15] : A_[(O_) + 14]; A_[(O_) + 14] = h_; A_[(O_) + 15] = l_; } } while (0)
#define MERGE16(T_) do { { const unsigned h_ = T_[0] > T_[8] ? T_[0] : T_[8], l_ = T_[0] > T_[8] ? T_[8] : T_[0]; T_[0] = h_; T_[8] = l_; } { const unsigned h_ = T_[1] > T_[9] ? T_[1] : T_[9], l_ = T_[1] > T_[9] ? T_[9] : T_[1]; T_[1] = h_; T_[9] = l_; } { const unsigned h_ = T_[2] > T_[10] ? T_[2] : T_[10], l_ = T_[2] > T_[10] ? T_[10] : T_[2]; T_[2] = h_; T_[10] = l_; } { const unsigned h_ = T_[3] > T_[11] ? T_[3] : T_[11], l_ = T_[3] > T_[11] ? T_[11] : T_[3]; T_[3] = h_; T_[11] = l_; } { const unsigned h_ = T_[4] > T_[12] ? T_[4] : T_[12], l_ = T_[4] > T_[12] ? T_[12] : T_[4]; T_[4] = h_; T_[12] = l_; } { const unsigned h_ = T_[5] > T_[13] ? T_[5] : T_[13], l_ = T_[5] > T_[13] ? T_[13] : T_[5]; T_[5] = h_; T_[13] = l_; } { const unsigned h_ = T_[6] > T_[14] ? T_[6] : T_[14], l_ = T_[6] > T_[14] ? T_[14] : T_[6]; T_[6] = h_; T_[14] = l_; } { const unsigned h_ = T_[7] > T_[15] ? T_[7] : T_[15], l_ = T_[7] > T_[15] ? T_[15] : T_[7]; T_[7] = h_; T_[15] = l_; } { const unsigned h_ = T_[0] > T_[4] ? T_[0] : T_[4], l_ = T_[0] > T_[4] ? T_[4] : T_[0]; T_[0] = h_; T_[4] = l_; } { const unsigned h_ = T_[1] > T_[5] ? T_[1] : T_[5], l_ = T_[1] > T_[5] ? T_[5] : T_[1]; T_[1] = h_; T_[5] = l_; } { const unsigned h_ = T_[2] > T_[6] ? T_[2] : T_[6], l_ = T_[2] > T_[6] ? T_[6] : T_[2]; T_[2] = h_; T_[6] = l_; } { const unsigned h_ = T_[3] > T_[7] ? T_[3] : T_[7], l_ = T_[3] > T_[7] ? T_[7] : T_[3]; T_[3] = h_; T_[7] = l_; } { const unsigned h_ = T_[8] > T_[12] ? T_[8] : T_[12], l_ = T_[8] > T_[12] ? T_[12] : T_[8]; T_[8] = h_; T_[12] = l_; } { const unsigned h_ = T_[9] > T_[13] ? T_[9] : T_[13], l_ = T_[9] > T_[13] ? T_[13] : T_[9]; T_[9] = h_; T_[13] = l_; } { const unsigned h_ = T_[10] > T_[14] ? T_[10] : T_[14], l_ = T_[10] > T_[14] ? T_[14] : T_[10]; T_[10] = h_; T_[14] = l_; } { const unsigned h_ = T_[11] > T_[15] ? T_[11] : T_[15], l_ = T_[11] > T_[15] ? T_[15] : T_[11]; T_[11] = h_; T_[15] = l_; } { const unsigned h_ = T_[0] > T_[2] ? T_[0] : T_[2], l_ = T_[0] > T_[2] ? T_[2] : T_[0]; T_[0] = h_; T_[2] = l_; } { const unsigned h_ = T_[1] > T_[3] ? T_[1] : T_[3], l_ = T_[1] > T_[3] ? T_[3] : T_[1]; T_[1] = h_; T_[3] = l_; } { const unsigned h_ = T_[4] > T_[6] ? T_[4] : T_[6], l_ = T_[4] > T_[6] ? T_[6] : T_[4]; T_[4] = h_; T_[6] = l_; } { const unsigned h_ = T_[5] > T_[7] ? T_[5] : T_[7], l_ = T_[5] > T_[7] ? T_[7] : T_[5]; T_[5] = h_; T_[7] = l_; } { const unsigned h_ = T_[8] > T_[10] ? T_[8] : T_[10], l_ = T_[8] > T_[10] ? T_[10] : T_[8]; T_[8] = h_; T_[10] = l_; } { const unsigned h_ = T_[9] > T_[11] ? T_[9] : T_[11], l_ = T_[9] > T_[11] ? T_[11] : T_[9]; T_[9] = h_; T_[11] = l_; } { const unsigned h_ = T_[12] > T_[14] ? T_[12] : T_[14], l_ = T_[12] > T_[14] ? T_[14] : T_[12]; T_[12] = h_; T_[14] = l_; } { const unsigned h_ = T_[13] > T_[15] ? T_[13] : T_[15], l_ = T_[13] > T_[15] ? T_[15] : T_[13]; T_[13] = h_; T_[15] = l_; } { const unsigned h_ = T_[0] > T_[1] ? T_[0] : T_[1], l_ = T_[0] > T_[1] ? T_[1] : T_[0]; T_[0] = h_; T_[1] = l_; } { const unsigned h_ = T_[2] > T_[3] ? T_[2] : T_[3], l_ = T_[2] > T_[3] ? T_[3] : T_[2]; T_[2] = h_; T_[3] = l_; } { const unsigned h_ = T_[4] > T_[5] ? T_[4] : T_[5], l_ = T_[4] > T_[5] ? T_[5] : T_[4]; T_[4] = h_; T_[5] = l_; } { const unsigned h_ = T_[6] > T_[7] ? T_[6] : T_[7], l_ = T_[6] > T_[7] ? T_[7] : T_[6]; T_[6] = h_; T_[7] = l_; } { const unsigned h_ = T_[8] > T_[9] ? T_[8] : T_[9], l_ = T_[8] > T_[9] ? T_[9] : T_[8]; T_[8] = h_; T_[9] = l_; } { const unsigned h_ = T_[10] > T_[11] ? T_[10] : T_[11], l_ = T_[10] > T_[11] ? T_[11] : T_[10]; T_[10] = h_; T_[11] = l_; } { const unsigned h_ = T_[12] > T_[13] ? T_[12] : T_[13], l_ = T_[12] > T_[13] ? T_[13] : T_[12]; T_[12] = h_; T_[13] = l_; } { const unsigned h_ = T_[14] > T_[15] ? T_[14] : T_[15], l_ = T_[14] > T_[15] ? T_[15] : T_[14]; T_[14] = h_; T_[15] = l_; } } while (0)

namespace peer {
__device__ __forceinline__ unsigned f2ord(float f) { const unsigned u = __builtin_bit_cast(unsigned, f); return u ^ ((unsigned)((int)u >> 31) | 0x80000000u); }
__device__ __forceinline__ float ord2f(unsigned o) { const unsigned u = (o & 0x80000000u) ? (o ^ 0x80000000u) : ~o; return __builtin_bit_cast(float, u); }
__device__ __forceinline__ unsigned pair_max(unsigned v) { auto rr = __builtin_amdgcn_permlane32_swap(v, v, false, false); return rr[0] > rr[1] ? rr[0] : rr[1]; }

template <int C_> __device__ __forceinline__ void route_half(int r32, int hi, int tok0, int h, const bf16_t* __restrict__ PQ, const bf16_t* __restrict__ SK, unsigned (&kt)[16]) {
    const bf16_t* skb = SK + (size_t)((h * 2 + C_) * 128) * 128;
    f32x16 acc[4] = {};
    const bf16_t* qrow = PQ + (size_t)(tok0 + r32) * DM + (h * 2 + C_) * 128 + 8 * hi;
#pragma unroll
    for (int t = 0; t < 8; ++t) {
        const bf16x8 b = *(const bf16x8*)(qrow + 16 * t);
#pragma unroll
        for (int kq = 0; kq < 4; ++kq) { const bf16x8 a = *(const bf16x8*)(skb + (size_t)(32 * kq + r32) * 128 + 16 * t + 8 * hi);
            acc[kq] = __builtin_amdgcn_mfma_f32_32x32x16_bf16(a, b, acc[kq], 0, 0, 0); }
    }
    unsigned key[64];
#pragma unroll
    for (int kq = 0; kq < 4; ++kq)
#pragma unroll
        for (int r = 0; r < 16; ++r) key[kq * 16 + r] = (f2ord(acc[kq][r]) & ~127u) | (unsigned)(127 - (32 * kq + (r & 3) + 8 * (r >> 2)) - 4 * hi);
    SORT16(key, 0); SORT16(key, 16); SORT16(key, 32); SORT16(key, 48);
    unsigned t0[16], t1[16];
#pragma unroll
    for (int i = 0; i < 16; ++i) { t0[i] = key[i] > key[31 - i] ? key[i] : key[31 - i]; t1[i] = key[32 + i] > key[63 - i] ? key[32 + i] : key[63 - i]; }
    MERGE16(t0); MERGE16(t1);
#pragma unroll
    for (int i = 0; i < 16; ++i) t0[i] = t0[i] > t1[15 - i] ? t0[i] : t1[15 - i];
    MERGE16(t0);
#pragma unroll
    for (int i = 0; i < 16; ++i) { const unsigned u = t0[15 - i]; auto rr = __builtin_amdgcn_permlane32_swap(u, u, false, false); const unsigned pu = hi ? rr[0] : rr[1];
        kt[i] = t0[i] > pu ? t0[i] : pu; }
    MERGE16(kt);
}
__device__ __forceinline__ void route_unit(int lane, int tok0, int h, const bf16_t* __restrict__ PQ, const bf16_t* __restrict__ SK, int* __restrict__ experts, float* __restrict__ pgates, LAS unsigned* rt) {
    const int r32 = lane & 31, hi = lane >> 5;
    unsigned kt0[16], kt1[16];
    route_half<0>(r32, hi, tok0, h, PQ, SK, kt0); SBAR();
    route_half<1>(r32, hi, tok0, h, PQ, SK, kt1); SBAR();
    unsigned ck[64];
    { int n = 0;
#pragma unroll
      for (int a = 0; a < 16; ++a)
#pragma unroll
        for (int b = 0; b < 16; ++b) if ((a + 1) * (b + 1) <= 16) { ck[n] = (f2ord(ord2f(kt0[a] & ~127u) + ord2f(kt1[b] & ~127u)) & ~255u) | (unsigned)(255 - (a * 16 + b)); ++n; }
#pragma unroll
      for (int z = 50; z < 64; ++z) ck[z] = 0u; }
    SBAR();
    SORT16(ck, 0); SORT16(ck, 16); SORT16(ck, 32); SORT16(ck, 48);
    unsigned c0[16], c1[16];
#pragma unroll
    for (int i = 0; i < 16; ++i) { c0[i] = ck[i] > ck[31 - i] ? ck[i] : ck[31 - i]; c1[i] = ck[32 + i] > ck[63 - i] ? ck[32 + i] : ck[63 - i]; }
    MERGE16(c0); MERGE16(c1);
#pragma unroll
    for (int i = 0; i < 16; ++i) c0[i] = c0[i] > c1[15 - i] ? c0[i] : c1[15 - i];
    MERGE16(c0);
#pragma unroll
    for (int a = 0; a < 16; ++a) { rt[a * 64 + lane] = kt0[a]; rt[(16 + a) * 64 + lane] = kt1[a]; }
    float bs[16]; int be[16];
#pragma unroll
    for (int p = 0; p < 16; ++p) { const unsigned best = c0[p];
        const int flat = 255 - (int)(best & 255u), ia = flat >> 4, ib = flat & 15;
        const unsigned ka = rt[ia * 64 + lane], kb = rt[(16 + ib) * 64 + lane];
        bs[p] = ord2f(best & ~255u); be[p] = (127 - (int)(ka & 127u)) * 128 + (127 - (int)(kb & 127u)); }
    float es[16]; float sum = 0.f;
#pragma unroll
    for (int p = 0; p < 16; ++p) { es[p] = __expf(bs[p] - bs[0]); sum += es[p]; }
    const float inv = 1.0f / sum;
    if (hi == 0) { int* ep = experts + (size_t)(tok0 + r32) * 128 + h * 16;
#pragma unroll
        for (int g = 0; g < 4; ++g) *(int4*)(ep + 4 * g) = make_int4(be[4 * g], be[4 * g + 1], be[4 * g + 2], be[4 * g + 3]);
    } else { float* gp = pgates + (size_t)(tok0 + r32) * 128 + h * 16;
#pragma unroll
        for (int g = 0; g < 4; ++g) *(f32x4*)(gp + 4 * g) = (f32x4){es[4 * g] * inv, es[4 * g + 1] * inv, es[4 * g + 2] * inv, es[4 * g + 3] * inv}; }
}

__device__ __forceinline__ float gelu_exact(float v) { return 0.5f * v * (1.0f + erff(v * 0.70710678118654752f)); }

__device__ __forceinline__ unsigned fp6_code(float y) {
    const float a = fabsf(y);
    const float mult = a < 2.0f ? 8.0f : (a < 4.0f ? 4.0f : 2.0f); const unsigned base = a < 2.0f ? 0u : (a < 4.0f ? 8u : 16u);
    unsigned c = base + (unsigned)__builtin_rintf(a * mult); c = c > 31u ? 31u : c;
    return c | ((__builtin_bit_cast(unsigned, y) >> 31) << 5);
}
typedef unsigned u32x6 __attribute__((ext_vector_type(6)));
typedef float f32x32 __attribute__((ext_vector_type(32)));
__device__ __forceinline__ void quant_row_fp6(int lane, const float* __restrict__ src, unsigned char* __restrict__ dst, float* __restrict__ scale_out) {
    f32x4 v[8]; float am = 0.f;
#pragma unroll
    for (int j = 0; j < 8; ++j) { v[j] = *(const f32x4*)(src + 256 * j + 4 * lane);
        am = fmaxf(am, fmaxf(fmaxf(fabsf(v[j][0]), fabsf(v[j][1])), fmaxf(fabsf(v[j][2]), fabsf(v[j][3])))); }
    am = wave_max(am);
    const float sc = am > 0.f ? 7.5f / am : 1.0f;
    if (lane == 0) *scale_out = am > 0.f ? am * (1.0f / 7.5f) : 1.0f;
    unsigned long long lo = 0ull, mid = 0ull, hi = 0ull;
    unsigned w[6] = {0u, 0u, 0u, 0u, 0u, 0u};
#pragma unroll
    for (int e = 0; e < 32; ++e) { const unsigned c = fp6_code(v[e >> 2][e & 3] * sc); const int bit = 6 * e, d = bit >> 5, sh = bit & 31;
        w[d] |= c << sh; if (sh > 26) w[d + 1] |= c >> (32 - sh); }
    (void)lo; (void)mid; (void)hi;
    *(u32x4*)(dst + 16 * lane) = (u32x4){w[0], w[1], w[2], w[3]};
    *(u32x2*)(dst + 1024 + 8 * lane) = (u32x2){w[4], w[5]};
}

__device__ __forceinline__ unsigned fp4_code(float y) { const float a = fabsf(y);
    const unsigned idx = (unsigned)(a > 0.25f) + (unsigned)(a > 0.75f) + (unsigned)(a > 1.25f) + (unsigned)(a > 1.75f) + (unsigned)(a > 2.5f) + (unsigned)(a > 3.5f) + (unsigned)(a > 5.0f);
    return idx | ((__builtin_bit_cast(unsigned, y) >> 31) << 3); }
__device__ __forceinline__ void quant_row_fp4(int lane, const float* __restrict__ src, unsigned char* __restrict__ dst, float* __restrict__ scale_out) {
    f32x4 v[8]; float am = 0.f;
#pragma unroll
    for (int j = 0; j < 8; ++j) { v[j] = *(const f32x4*)(src + 256 * j + 4 * lane);
        am = fmaxf(am, fmaxf(fmaxf(fabsf(v[j][0]), fabsf(v[j][1])), fmaxf(fabsf(v[j][2]), fabsf(v[j][3])))); }
    am = wave_max(am);
    const float sc = am > 0.f ? 6.0f / am : 1.0f;
    if (lane == 0) *scale_out = am > 0.f ? am * (1.0f / 6.0f) : 1.0f;
    unsigned w[4] = {0u, 0u, 0u, 0u};
#pragma unroll
    for (int e = 0; e < 32; ++e) w[e >> 3] |= fp4_code(v[e >> 2][e & 3] * sc) << (4 * (e & 7));
    *(u32x4*)(dst + 16 * lane) = (u32x4){w[0], w[1], w[2], w[3]};
}
__device__ __forceinline__ void quant_rows2_fp4(int lane, const float* __restrict__ s0, const float* __restrict__ s1, unsigned char* __restrict__ d0, unsigned char* __restrict__ d1, float* __restrict__ sc0, float* __restrict__ sc1) {
    f32x4 v[2][8]; float am[2] = {0.f, 0.f};
#pragma unroll
    for (int j = 0; j < 8; ++j) { v[0][j] = *(const f32x4*)(s0 + 256 * j + 4 * lane); v[1][j] = *(const f32x4*)(s1 + 256 * j + 4 * lane); }
#pragma unroll
    for (int r = 0; r < 2; ++r)
#pragma unroll
        for (int j = 0; j < 8; ++j) am[r] = fmaxf(am[r], fmaxf(fmaxf(fabsf(v[r][j][0]), fabsf(v[r][j][1])), fmaxf(fabsf(v[r][j][2]), fabsf(v[r][j][3]))));
#pragma unroll
    for (int o = 1; o < 64; o <<= 1) { am[0] = fmaxf(am[0], __shfl_xor(am[0], o)); am[1] = fmaxf(am[1], __shfl_xor(am[1], o)); }
#pragma unroll
    for (int r = 0; r < 2; ++r) { const float sc = am[r] > 0.f ? 6.0f / am[r] : 1.0f;
        if (lane == 0) *(r ? sc1 : sc0) = am[r] > 0.f ? am[r] * (1.0f / 6.0f) : 1.0f;
        unsigned w[4] = {0u, 0u, 0u, 0u};
#define QP_(d_, b_) w[d_] = __builtin_amdgcn_cvt_scalef32_pk_fp4_f32(w[d_], v[r][2 * (d_) + ((b_) >> 1)][2 * ((b_) & 1)] * sc, v[r][2 * (d_) + ((b_) >> 1)][2 * ((b_) & 1) + 1] * sc, 1.0f, b_)
#define QD_(d_) QP_(d_, 0); QP_(d_, 1); QP_(d_, 2); QP_(d_, 3)
        QD_(0); QD_(1); QD_(2); QD_(3);
#undef QD_
#undef QP_
        *(u32x4*)((r ? d1 : d0) + 16 * lane) = (u32x4){w[0], w[1], w[2], w[3]}; }
}

__device__ __forceinline__ float dpp_total(float v) {
#define DPPADD(ctrl, rmask) v += __builtin_bit_cast(float, __builtin_amdgcn_update_dpp(0, __builtin_bit_cast(int, v), ctrl, rmask, 0xf, true))
    DPPADD(0xB1, 0xf); DPPADD(0x4E, 0xf); DPPADD(0x141, 0xf); DPPADD(0x140, 0xf); DPPADD(0x142, 0xa); DPPADD(0x143, 0xc);
#undef DPPADD
    return __builtin_bit_cast(float, __builtin_amdgcn_readlane(__builtin_bit_cast(int, v), 63));
}
#ifndef PEER_FP4
#define PEER_FP4 1
#endif
#if PEER_FP4
constexpr int ROWB = 1024;
struct Row6 { u32x4 a; };
#define LOADROW(W_, TAB_, i_) do { const int e_ = __builtin_amdgcn_readlane((i_) < 64 ? ev0 : ev1, (i_) & 63); W_.a = *(const u32x4*)((TAB_) + (size_t)e_ * ROWB + 16 * lane); } while (0)
struct F2x16 { f32x2 p[16]; };
__device__ __forceinline__ F2x16 dec32_fp4(const u32x4 w) { F2x16 f;
#pragma unroll
    for (int d = 0; d < 4; ++d) { f.p[4 * d] = __builtin_amdgcn_cvt_scalef32_pk_f32_fp4(w[d], 1.0f, 0); f.p[4 * d + 1] = __builtin_amdgcn_cvt_scalef32_pk_f32_fp4(w[d], 1.0f, 1);
        f.p[4 * d + 2] = __builtin_amdgcn_cvt_scalef32_pk_f32_fp4(w[d], 1.0f, 2); f.p[4 * d + 3] = __builtin_amdgcn_cvt_scalef32_pk_f32_fp4(w[d], 1.0f, 3); }
    return f; }
#define DEC32(W_) dec32_fp4(W_.a)
#else
constexpr int ROWB = 1536;
struct Row6 { u32x4 a; u32x2 b; };
#define LOADROW(W_, TAB_, i_) do { const int e_ = __builtin_amdgcn_readlane((i_) < 64 ? ev0 : ev1, (i_) & 63); const unsigned char* p_ = (TAB_) + (size_t)e_ * ROWB; \
        W_.a = *(const u32x4*)(p_ + 16 * lane); W_.b = *(const u32x2*)(p_ + 1024 + 8 * lane); } while (0)
struct F2x16 { f32x2 p[16]; };
__device__ __forceinline__ F2x16 dec32_fp6(const u32x4 a, const u32x2 b) { const f32x32 v = __builtin_amdgcn_cvt_scalef32_pk32_f32_fp6((u32x6){a[0], a[1], a[2], a[3], b[0], b[1]}, 1.0f); F2x16 f;
#pragma unroll
    for (int i = 0; i < 16; ++i) f.p[i] = (f32x2){v[2 * i], v[2 * i + 1]};
    return f; }
#define DEC32(W_) dec32_fp6(W_.a, W_.b)
#endif
__device__ __forceinline__ void gather_token(int lane_in, int tok, const f32x2* __restrict__ ST, const float* __restrict__ g2, const float* __restrict__ b2, const bf16_t* __restrict__ ZB, float* XO, const unsigned char* __restrict__ U8, const unsigned char* __restrict__ V8,
                                             const float* __restrict__ USC, const float* __restrict__ VSC, const int* __restrict__ experts, const float* __restrict__ pgates,
                                             const float* __restrict__ g3, const float* __restrict__ b3) {
    int lane = lane_in; asm volatile("" : "+v"(lane));
    f32x2 xr[16];
    { const f32x2 pp = lane < 32 ? ST[(size_t)tok * 32 + lane] : (f32x2){0.f, 0.f}; const f32x2 pv = {wave_sum(pp[0]), wave_sum(pp[1])}; const float mean = pv[0] * (1.f / DM); const float rstd = 1.f / sqrtf(fmaxf(pv[1] * (1.f / DM) - mean * mean, 0.f) + LN_EPS);
#pragma unroll
      for (int j = 0; j < 8; ++j) { const int c0 = 256 * j + 4 * lane; const u32x2 zw = *(const u32x2*)(ZB + (size_t)tok * DM + c0); const f32x4 gg = *(const f32x4*)(g2 + c0), bb = *(const f32x4*)(b2 + c0);
        xr[2 * j] = (f32x2){(bflo(zw[0]) - mean) * rstd * gg[0] + bb[0], (bfhi(zw[0]) - mean) * rstd * gg[1] + bb[1]};
        xr[2 * j + 1] = (f32x2){(bflo(zw[1]) - mean) * rstd * gg[2] + bb[2], (bfhi(zw[1]) - mean) * rstd * gg[3] + bb[3]}; } }
    const int ev0 = experts[(size_t)tok * 128 + lane], ev1 = experts[(size_t)tok * 128 + 64 + lane];
    float sv0 = 0.f, sv1 = 0.f;
    Row6 wA[4], wB[4];
#define UPART(W_, P_) do { const F2x16 f = DEC32(W_); f32x2 sa_ = {0.f, 0.f}, sb_ = {0.f, 0.f}; _Pragma("unroll") for (int e_ = 0; e_ < 16; e_ += 2) { sa_ = __builtin_elementwise_fma(f.p[e_], xr[e_], sa_); sb_ = __builtin_elementwise_fma(f.p[e_ + 1], xr[e_ + 1], sb_); } \
        sa_ += sb_; P_ = sa_[0] + sa_[1]; SBAR(); } while (0)
#define DPPF(v, ctrl, rm, bm) __builtin_bit_cast(float, __builtin_amdgcn_update_dpp(0, __builtin_bit_cast(int, (float)(v)), ctrl, rm, bm, false))
    const bool lb0 = lane & 1, lb1 = lane & 2, lb2 = lane & 4; const int lgrp = lane >> 3;
    float ps[8];
#pragma unroll
    for (int q = 0; q < 4; ++q) LOADROW(wA[q], U8, q);
#pragma unroll 1
    for (int i0 = 0; i0 < 128; i0 += 8) {
#pragma unroll
        for (int q = 0; q < 4; ++q) LOADROW(wB[q], U8, i0 + 4 + q);
        SBAR();
#pragma unroll
        for (int q = 0; q < 4; ++q) UPART(wA[q], ps[q]);
        if (i0 + 8 < 128) {
#pragma unroll
            for (int q = 0; q < 4; ++q) LOADROW(wA[q], U8, i0 + 8 + q); }
        SBAR();
#pragma unroll
        for (int q = 0; q < 4; ++q) UPART(wB[q], ps[4 + q]);
        float t1[4], t2[2];
#pragma unroll
        for (int k = 0; k < 4; ++k) { const float keep = lb0 ? ps[2 * k + 1] : ps[2 * k], send = lb0 ? ps[2 * k] : ps[2 * k + 1]; t1[k] = keep + DPPF(send, 0xB1, 0xf, 0xf); }
#pragma unroll
        for (int m = 0; m < 2; ++m) { const float keep = lb1 ? t1[2 * m + 1] : t1[2 * m], send = lb1 ? t1[2 * m] : t1[2 * m + 1]; t2[m] = keep + DPPF(send, 0x4E, 0xf, 0xf); }
        float rr; { const float keep = lb2 ? t2[1] : t2[0], send = lb2 ? t2[0] : t2[1]; rr = keep + DPPF(send, 0x104, 0xf, 0x5) + DPPF(send, 0x114, 0xf, 0xa); }
        rr += DPPF(rr, 0x128, 0xf, 0xf);
        { auto s16 = __builtin_amdgcn_permlane16_swap(__float_as_uint(rr), __float_as_uint(rr), false, false); rr = __uint_as_float(s16[0]) + __uint_as_float(s16[1]); }
        { auto s32 = __builtin_amdgcn_permlane32_swap(__float_as_uint(rr), __float_as_uint(rr), false, false); rr = __uint_as_float(s32[0]) + __uint_as_float(s32[1]); }
        const bool mine = lgrp == ((i0 >> 3) & 7);
        if (i0 < 64) sv0 = mine ? rr : sv0; else sv1 = mine ? rr : sv1;
        SBAR();
    }
#undef UPART
#undef DPPF
    const float av0 = gelu_exact(sv0 * USC[ev0]) * pgates[(size_t)tok * 128 + lane] * VSC[ev0];
    const float av1 = gelu_exact(sv1 * USC[ev1]) * pgates[(size_t)tok * 128 + 64 + lane] * VSC[ev1];
    f32x2 acc2[16];
#pragma unroll
    for (int e = 0; e < 16; ++e) acc2[e] = (f32x2){0.f, 0.f};
#define VROW(W_, i_) do { const float a_ = __builtin_bit_cast(float, __builtin_amdgcn_readlane(__builtin_bit_cast(int, (i_) < 64 ? av0 : av1), (i_) & 63)); \
        const F2x16 f = DEC32(W_); const f32x2 a2_ = {a_, a_}; _Pragma("unroll") for (int e_ = 0; e_ < 16; ++e_) acc2[e_] = __builtin_elementwise_fma(f.p[e_], a2_, acc2[e_]); SBAR(); } while (0)
#pragma unroll
    for (int q = 0; q < 4; ++q) LOADROW(wA[q], V8, q);
#pragma unroll 1
    for (int i0 = 0; i0 < 128; i0 += 8) {
#pragma unroll
        for (int q = 0; q < 4; ++q) LOADROW(wB[q], V8, i0 + 4 + q);
        SBAR();
#pragma unroll
        for (int q = 0; q < 4; ++q) VROW(wA[q], i0 + q);
        if (i0 + 8 < 128) {
#pragma unroll
            for (int q = 0; q < 4; ++q) LOADROW(wA[q], V8, i0 + 8 + q); }
        SBAR();
#pragma unroll
        for (int q = 0; q < 4; ++q) VROW(wB[q], i0 + 4 + q);
    }
#undef VROW
    asm volatile("" : "+v"(lane) :: "memory");
    float* orow = XO + (size_t)tok * DM; float s = 0.f; float acc[32];
#pragma unroll
    for (int e = 0; e < 16; ++e) { acc[2 * e] = acc2[e][0] + ALPHA * xr[e][0]; acc[2 * e + 1] = acc2[e][1] + ALPHA * xr[e][1]; s += acc[2 * e] + acc[2 * e + 1]; }
    const float mean = wave_sum(s) * (1.f / DM); float s2 = 0.f;
#pragma unroll
    for (int e = 0; e < 32; ++e) { acc[e] -= mean; s2 += acc[e] * acc[e]; }
    const float rstd = 1.f / sqrtf(wave_sum(s2) * (1.f / DM) + LN_EPS);
#pragma unroll
    for (int j = 0; j < 8; ++j) { const int c0 = 256 * j + 4 * lane;
        const f32x4 ga = *(const f32x4*)(g3 + c0), ba = *(const f32x4*)(b3 + c0); f32x4 oa;
#pragma unroll
        for (int e = 0; e < 4; ++e) oa[e] = acc[4 * j + e] * rstd * ga[e] + ba[e];
        *(f32x4*)(orow + c0) = oa; }
}
#undef DEC32
#undef LOADROW
}

#if PEER_FP4
#define PEER_QUANT peer::quant_row_fp4
#else
#define PEER_QUANT peer::quant_row_fp6
#endif
#ifndef MK_ONE_LAUNCH
#define MK_ONE_LAUNCH 1
#endif
#ifndef MK_DUP
#define MK_DUP 0
#endif
#define DUP(b) ((MK_DUP >> (b)) & 1)
#ifndef MK_CG_SYNC
#define MK_CG_SYNC 0
#endif
constexpr int NPH = 16;
struct Args { GAS const float* in[23]; GAS float* out; GAS unsigned char* ws; int ph_lo, ph_hi; };
typedef const __attribute__((address_space(4))) Args* ArgsP;
__device__ __forceinline__ ArgsP get_args() { size_t z = 0; asm volatile("" : "+s"(z)); return (ArgsP)((const __attribute__((address_space(4))) char*)__builtin_amdgcn_kernarg_segment_ptr() + z); }
#define AIN(i) ((const float*)A->in[i])
#define AOUT ((float*)A->out)
enum { I_X = 0, I_MEM, I_WIN, I_BIG, I_BFG, I_AQN, I_AKN, I_MLN, I_WOUT, I_LN1G, I_LN1B, I_XWQ, I_XWK, I_XWV, I_XWO, I_LN2G, I_LN2B, I_PWQ, I_PSK, I_PU, I_PV, I_LN3G, I_LN3B };

struct SGemmOrder {
    const bf16_t* Q2; const bf16_t* K2; int G, c;
    __device__ bool next(int i, pg8::Unit& u) const { const int L = i * G + c; if (L >= 256) return false; u.pm = L >> 2; u.pn = L & 3;
        u.a = (const char*)(Q2 + (size_t)u.pm * 256 * DM + u.pn * 512); u.b = (const char*)(K2 + (size_t)(u.pm >> 4) * 256 * DM + u.pn * 512); return true; }
};
struct PVGemmOrder {
    const bf16_t* P; const bf16_t* V2T; int G, c;
    __device__ bool next(int i, pg8::Unit& u) const { const int L = i * G + c; if (L >= 512) return false; u.pm = L >> 3; u.pn = L & 7;
        u.a = (const char*)(P + (size_t)u.pm * 256 * 1024 + (u.pn >> 1) * 256); u.b = (const char*)(V2T + (size_t)u.pn * 256 * 1024 + (u.pm >> 4) * 256); return true; }
};

__device__ __forceinline__ unsigned lane_now() { unsigned z0 = 0u; asm volatile("" : "+v"(z0)); return __builtin_amdgcn_mbcnt_hi(~0u, __builtin_amdgcn_mbcnt_lo(~0u, z0)); }
__device__ __forceinline__ Ctx mk_ctx(unsigned char* lds_raw, int wave_s) {
    Ctx C; int wv = wave_s; asm volatile("" : "+s"(wv));
    unsigned z0 = 0u; asm volatile("" : "+v"(z0));
    int tid = wv * 64 + (int)__builtin_amdgcn_mbcnt_hi(~0u, __builtin_amdgcn_mbcnt_lo(~0u, z0)); asm volatile("" : "+v"(tid));
    int bx = blockIdx.x; asm volatile("" : "+s"(bx)); int G = gridDim.x; asm volatile("" : "+s"(G));
    C.lds = (LAS unsigned char*)lds_raw; C.tid = tid; C.lane = tid & 63; C.wave = wv;
    C.G = G; C.vcu = (G % 8 == 0) ? (bx % 8) * (G / 8) + bx / 8 : bx; C.bx = bx;
    C.gw = C.vcu * NWAVES + C.wave; C.NGW = G * NWAVES; return C;
}
#define WSP(T, off) ((T*)(ws + (off)))

__device__ __forceinline__ void phase0(unsigned char* lds_raw, int wave_s) {
    const Ctx C = mk_ctx(lds_raw, wave_s); const ArgsP A = get_args(); unsigned char* ws = (unsigned char*)A->ws;
    LAS float* scr = (LAS float*)(C.lds + C.wave * 16384);
    constexpr int I_W = 32 * 152, I_S = 32 * 64;
    for (int it = C.gw; it < I_W + 6 * I_S; it += C.NGW) {
        int r = it;
        if (r < I_W) { p0_transpose_item(AIN(I_WIN), DM, IN_TOTAL, WSP(bf16_t, WS_WIN), scr, r, 152, C.lane); continue; } r -= I_W;
        const int which = r / I_S; r -= which * I_S;
        const float* W = which == 0 ? AIN(I_WOUT) : which == 1 ? AIN(I_XWQ) : which == 2 ? AIN(I_XWK) : which == 3 ? AIN(I_XWV) : which == 4 ? AIN(I_XWO) : AIN(I_PWQ);
        bf16_t* WT = WSP(bf16_t, WS_WOUT + (size_t)which * 8 * MiB);
        if (which == 1) p0_transpose_item(W, DM, DM, WT, scr, r, 64, C.lane, AIN(I_LN1G), AIN(I_LN1B), WSP(float, WS_CSP), WSP(float, WS_CSP + 262144), WSP(bf16_t, WS_WQN));
        else if (which == 5) p0_transpose_item(W, DM, DM, WT, scr, r, 64, C.lane, AIN(I_LN2G), AIN(I_LN2B), WSP(float, WS_CSP + 524288), WSP(float, WS_CSP + 786432));
        else p0_transpose_item(W, DM, DM, WT, scr, r, 64, C.lane);
    }
    p0_convert(C, AIN(I_X), WSP(bf16_t, WS_XN), (long)NT * DM / 8);
    p0_convert(C, AIN(I_MEM), WSP(bf16_t, WS_MEMB), (long)NMEM * DM / 8);
    p0_convert(C, AIN(I_PSK), WSP(bf16_t, WS_SK), 8L * 2 * 128 * 128 / 8);
#if PEER_FP4
    for (int e = C.gw; e < NEXP; e += C.NGW)
        peer::quant_rows2_fp4(C.lane, AIN(I_PU) + (size_t)e * DM, AIN(I_PV) + (size_t)e * DM, WSP(unsigned char, WS_UB) + (size_t)e * peer::ROWB, WSP(unsigned char, WS_VB) + (size_t)e * peer::ROWB, WSP(float, WS_USC) + e, WSP(float, WS_VSC) + e);
#else
    for (int r = C.gw; r < 2 * NEXP; r += C.NGW) { const int isv = r >= NEXP, e = isv ? r - NEXP : r;
        PEER_QUANT(C.lane, AIN(isv ? I_PV : I_PU) + (size_t)e * DM, WSP(unsigned char, isv ? WS_VB : WS_UB) + (size_t)e * peer::ROWB, WSP(float, isv ? WS_VSC : WS_USC) + e); }
#endif
}
__device__ __forceinline__ void phase1(unsigned char* lds_raw, int wave_s) {
    const Ctx C = mk_ctx(lds_raw, wave_s); const ArgsP A = get_args(); unsigned char* ws = (unsigned char*)A->ws;
    { pg8::PlainOrder S; S.init(WSP(bf16_t, WS_XN), WSP(bf16_t, WS_WIN), DM, DM, NT, NPAD, C.G, C.bx); pg8::EpiH E{WSP(bf16_t, WS_H), WSP(float, WS_GATES)};
      pg8::gemm_phase(C.lds, C.tid, C.wave, pg8::Gemm{DM, DM, DM}, S, E); }
    { pg8::PlainOrder S; S.init(WSP(bf16_t, WS_MEMB), WSP(bf16_t, WS_XWK), DM, DM, NMEM, DM, C.G, C.bx, 192); pg8::EpiBf16 E{WSP(bf16_t, WS_K2), DM, 1.0f};
      pg8::gemm_phase(C.lds, C.tid, C.wave, pg8::Gemm{DM, DM, DM}, S, E); }
    { pg8::PlainOrder S; S.init(WSP(bf16_t, WS_MEMB), WSP(bf16_t, WS_XWV), DM, DM, NMEM, DM, C.G, C.bx, 224); pg8::EpiBf16 E{WSP(bf16_t, WS_V2T), DM, 1.0f};
      pg8::gemm_phase(C.lds, C.tid, C.wave, pg8::Gemm{DM, DM, DM}, S, E); }
}
constexpr int CW_KRDY = 1024;
__device__ __forceinline__ void phase3a(unsigned char* lds_raw, int wave_s) {
    const Ctx C = mk_ctx(lds_raw, wave_s); const ArgsP A = get_args(); unsigned char* ws = (unsigned char*)A->ws;
    pass_knormrope(C, WSP(bf16_t, WS_H), AIN(I_AKN));
    VM_WAIT(); __syncthreads();
    if (C.tid == 0) { __builtin_amdgcn_fence(__ATOMIC_RELEASE, "agent"); VM_WAIT(); (void)xb_add(WSP(unsigned, WS_CTL) + CW_KRDY, 1u); }
    bf16_t* HF = (bf16_t*)AOUT; bf16_t* HBk = (bf16_t*)AOUT + (size_t)NT * 1024;
    for (int it = C.vcu; it < 256; it += C.G) { mlstm::item(C, it, WSP(bf16_t, WS_H), WSP(float, WS_GATES), AIN(I_BIG), AIN(I_BFG), HF, HBk); __syncthreads(); }
}
__device__ __forceinline__ void phase3b(unsigned char* lds_raw, int wave_s) {
    const Ctx C = mk_ctx(lds_raw, wave_s); const ArgsP A = get_args(); unsigned char* ws = (unsigned char*)A->ws;
    if (C.tid == 0) { unsigned sp = 0u; while (xb_ld(WSP(unsigned, WS_CTL) + CW_KRDY) < (unsigned)C.G) { __builtin_amdgcn_s_sleep(2); if (++sp > (1u << 22)) break; } __builtin_amdgcn_fence(__ATOMIC_ACQUIRE, "agent"); VM_WAIT(); }
    __syncthreads();
    bf16_t* Hb = WSP(bf16_t, WS_H); bf16_t* XN = WSP(bf16_t, WS_XN);
    for (int k = C.vcu; k < 512; k += C.G) {
        const int g8 = (k & 255) >> 5, idx = (k & 31) + 32 * (k >> 8);
        const int b = g8 >> 1, kvh = g8 & 1, qh = kvh * 4 + (idx >> 4), qb = idx & 15;
        const bf16_t* Qb = Hb + (size_t)(b * SEQ + qb * 256) * HP + C_AQ + qh * 128;
        const bf16_t* Kh = Hb + (size_t)(b * SEQ) * HP + C_AK + kvh * 128; const bf16_t* Vh = Hb + (size_t)(b * SEQ) * HP + C_AV + kvh * 128;
        bf16_t* Ob = XN + (size_t)(b * SEQ + qb * 256) * DM + qh * 128;
        attn::attn_dense_body(Qb, Kh, Vh, Ob, SEQ, (char*)lds_raw, C.tid, C.wave, AIN(I_AQN), qb * 256);
        __syncthreads();
    }
}
struct OneUnit { pg8::Unit u; __device__ bool next(int i, pg8::Unit& o) const { if (i) return false; o = u; return true; } };
__device__ __forceinline__ void phase4(unsigned char* lds_raw, int wave_s) { const Ctx C = mk_ctx(lds_raw, wave_s); const ArgsP A = get_args(); unsigned char* ws = (unsigned char*)A->ws;
    pass_mlpost(C, (const bf16_t*)AOUT, (const bf16_t*)AOUT + (size_t)NT * 1024, WSP(bf16_t, WS_H), AIN(I_MLN), WSP(bf16_t, WS_XN));
    for (int i = C.vcu * NTHREADS + C.tid; i < 4 * 2048; i += C.G * NTHREADS) { const float* pp = WSP(float, WS_CSP) + (size_t)(i >> 11) * 65536 + (i & 2047); float s = 0.f;
        for (int kb = 0; kb < 32; ++kb) s += pp[kb * 2048];
        WSP(float, WS_CS)[i] = s; }
    for (int L = C.bx; L < 256; L += C.G) { const int q = L & 127, b = q >> 5, h = (q >> 3) & 3, t8 = q & 7; const bool isv = L >= 128;
        OneUnit S; pg8::EpiBf16 E{nullptr, 0, 1.0f};
        if (!isv) { S.u.pm = b * 4 + h; S.u.pn = t8; S.u.a = (const char*)(WSP(bf16_t, WS_K2) + (size_t)(b * 256) * DM + h * 512); S.u.b = (const char*)(WSP(bf16_t, WS_WQN) + (size_t)(t8 * 256) * DM + h * 512); E.O = WSP(bf16_t, WS_MT); E.ldc = DM; }
        else { S.u.pm = b * 8 + t8; S.u.pn = h; S.u.a = (const char*)(WSP(bf16_t, WS_XWO) + (size_t)(t8 * 256) * DM + h * 512); S.u.b = (const char*)(WSP(bf16_t, WS_V2T) + (size_t)(b * 256) * DM + h * 512); E.O = WSP(bf16_t, WS_VWT); E.ldc = 1024; }
        int K = 512; asm volatile("" : "+s"(K));
        pg8::gemm_phase(C.lds, C.tid, C.wave, pg8::Gemm{DM, DM, K}, S, E); } }
#define LNTAB ((LAS f32x2*)(C.lds + LDSCTL_OFF + 1024))
__device__ __forceinline__ void phase5(unsigned char* lds_raw, int wave_s) {
    const Ctx C = mk_ctx(lds_raw, wave_s); const ArgsP A = get_args(); unsigned char* ws = (unsigned char*)A->ws;
    for (int o = C.gw; o < 4096; o += C.NGW) { const int b = o >> 10, j = o & 1023, h = j >> 8, key = j & 255;
        const u32x4 kv = *(const u32x4*)(WSP(bf16_t, WS_K2) + (size_t)(b * 256 + key) * DM + h * 512 + 8 * C.lane);
        const float* c1 = WSP(float, WS_CS) + h * 512 + 8 * C.lane; const float* b1 = c1 + 2048;
        const f32x4 ca = *(const f32x4*)c1, cb = *(const f32x4*)(c1 + 4), ba = *(const f32x4*)b1, bb = *(const f32x4*)(b1 + 4);
        const float k0 = bflo(kv.x), k1 = bfhi(kv.x), k2 = bflo(kv.y), k3 = bfhi(kv.y), k4 = bflo(kv.z), k5 = bfhi(kv.z), k6 = bflo(kv.w), k7 = bfhi(kv.w);
        float s1 = (k0 * ca[0] + k1 * ca[1]) + (k2 * ca[2] + k3 * ca[3]) + (k4 * cb[0] + k5 * cb[1]) + (k6 * cb[2] + k7 * cb[3]);
        float s2 = (k0 * ba[0] + k1 * ba[1]) + (k2 * ba[2] + k3 * ba[3]) + (k4 * bb[0] + k5 * bb[1]) + (k6 * bb[2] + k7 * bb[3]);
        s1 = wave_sum(s1); s2 = wave_sum(s2);
        if (C.lane == 0) { WSP(float, WS_CS2)[o] = s1; WSP(float, WS_CS2)[4096 + o] = s2; } }
    pg8::PlainOrder S; S.init(WSP(bf16_t, WS_XN), WSP(bf16_t, WS_WOUT), DM, DM, NT, DM, C.G, C.bx);
    pg8::EpiResStats<0> E{AIN(I_X), WSP(bf16_t, WS_ZB), WSP(f32x2, WS_ST1), nullptr, 0, nullptr, nullptr, ALPHA};
    pg8::gemm_phase(C.lds, C.tid, C.wave, pg8::Gemm{DM, DM, DM}, S, E);
}
__device__ __forceinline__ void phase_lnfold(unsigned char* lds_raw, int wave_s, size_t offB, size_t offO, size_t offST, size_t offCS) {
    const Ctx C = mk_ctx(lds_raw, wave_s); const ArgsP A = get_args(); unsigned char* ws = (unsigned char*)A->ws;
    pg8::PlainOrder S; S.init(WSP(bf16_t, WS_ZB), WSP(bf16_t, offB), DM, DM, NT, DM, C.G, C.bx);
    const int pm0 = pg8::ln_build_tables(WSP(f32x2, offST), S, C.tid, LNTAB);
    pg8::EpiLnFold E{WSP(bf16_t, offO), DM, LNTAB, pm0, WSP(float, offCS), WSP(float, offCS + 8192)};
    pg8::gemm_phase(C.lds, C.tid, C.wave, pg8::Gemm{DM, DM, DM}, S, E);
}
struct TwoUnits { pg8::Unit u0, u1; __device__ bool next(int i, pg8::Unit& o) const { if (i > 1) return false; o = i ? u1 : u0; return true; } };
__device__ __forceinline__ void phase_xattn(unsigned char* lds_raw, int wave_s) {
    { const Ctx C = mk_ctx(lds_raw, wave_s); const ArgsP A = get_args(); unsigned char* ws = (unsigned char*)A->ws;
      const bf16_t* Q2 = WSP(bf16_t, WS_Q2); const bf16_t* K2 = WSP(bf16_t, WS_K2); bf16_t* P = WSP(bf16_t, WS_XN);
      LAS float* tmax = (LAS float*)(C.lds + LDSCTL_OFF + 1024); LAS float* tsum = tmax + 1024;
      for (int L = C.bx; L < 256; L += C.G) { const int pm = L >> 2, h = L & 3;
          OneUnit S; S.u.pm = pm; S.u.pn = h; S.u.a = (const char*)(Q2 + (size_t)pm * 256 * DM + h * 512); S.u.b = (const char*)(K2 + (size_t)(pm >> 4) * 256 * DM + h * 512);
          pg8::EpiSoftmaxP E{P, 1024, 0.04419417382415922f, tmax, tsum}; int K = 512; asm volatile("" : "+s"(K));
          pg8::gemm_phase(C.lds, C.tid, C.wave, pg8::Gemm{DM, DM, K}, S, E); }
      VM_WAIT(); __syncthreads();
      if (C.tid == 0) { __builtin_amdgcn_fence(__ATOMIC_ACQUIRE, "agent"); VM_WAIT(); }
      __syncthreads(); }
    { const Ctx C = mk_ctx(lds_raw, wave_s); const ArgsP A = get_args(); unsigned char* ws = (unsigned char*)A->ws;
      const bf16_t* P = WSP(bf16_t, WS_XN); const bf16_t* V2T = WSP(bf16_t, WS_V2T);
      for (int L = C.bx; L < 256; L += C.G) { const int pm = L >> 2, h = L & 3;
          TwoUnits S; S.u0.pm = pm; S.u0.pn = 2 * h; S.u0.a = (const char*)(P + (size_t)pm * 256 * 1024 + h * 256); S.u0.b = (const char*)(V2T + (size_t)(2 * h) * 256 * 1024 + (pm >> 4) * 256);
          S.u1 = S.u0; S.u1.pn = 2 * h + 1; S.u1.b = (const char*)(V2T + (size_t)(2 * h + 1) * 256 * 1024 + (pm >> 4) * 256);
          pg8::EpiBf16 E{WSP(bf16_t, WS_O2), DM, 1.0f}; int K = 256; asm volatile("" : "+s"(K));
          pg8::gemm_phase(C.lds, C.tid, C.wave, pg8::Gemm{1024, 1024, K}, S, E); } }
}
__device__ __forceinline__ void phase8(unsigned char* lds_raw, int wave_s) {
    const Ctx C = mk_ctx(lds_raw, wave_s); const ArgsP A = get_args(); unsigned char* ws = (unsigned char*)A->ws;
    SGemmOrder S{WSP(bf16_t, WS_Q2), WSP(bf16_t, WS_K2), C.G, C.bx}; pg8::EpiF32 E{AOUT, 1024, 0.04419417382415922f};
    int K = 512; asm volatile("" : "+s"(K));
    pg8::gemm_phase(C.lds, C.tid, C.wave, pg8::Gemm{DM, DM, K}, S, E);
}
__device__ __forceinline__ void phase9(unsigned char* lds_raw, int wave_s) { const Ctx C = mk_ctx(lds_raw, wave_s); const ArgsP A = get_args(); unsigned char* ws = (unsigned char*)A->ws; pass_softmax(C, AOUT, WSP(bf16_t, WS_XN)); }
__device__ __forceinline__ void phase10(unsigned char* lds_raw, int wave_s) {
    const Ctx C = mk_ctx(lds_raw, wave_s); const ArgsP A = get_args(); unsigned char* ws = (unsigned char*)A->ws;
    PVGemmOrder S{WSP(bf16_t, WS_XN), WSP(bf16_t, WS_V2T), C.G, C.bx}; pg8::EpiBf16 E{WSP(bf16_t, WS_O2), DM, 1.0f};
    int K = 256; asm volatile("" : "+s"(K));
    pg8::gemm_phase(C.lds, C.tid, C.wave, pg8::Gemm{1024, 1024, K}, S, E);
}
__device__ __forceinline__ void phase_scores(unsigned char* lds_raw, int wave_s) {
    const Ctx C = mk_ctx(lds_raw, wave_s); const ArgsP A = get_args(); unsigned char* ws = (unsigned char*)A->ws;
    LAS f32x2* lntab = (LAS f32x2*)(C.lds + LDSCTL_OFF + 1024); LAS float* tmax = (LAS float*)(C.lds + LDSCTL_OFF + 1024 + 2048); LAS float* tsum = tmax + 1024;
    for (int L = C.bx; L < 256; L += C.G) { const int pm = L >> 2, h = L & 3, b = pm >> 4;
        pg8::ln_build_table(WSP(f32x2, WS_ST1), pm, C.tid, lntab); LDS_WAIT(); __syncthreads();
        OneUnit S; S.u.pm = pm; S.u.pn = h; S.u.a = (const char*)(WSP(bf16_t, WS_ZB) + (size_t)pm * 256 * DM); S.u.b = (const char*)(WSP(bf16_t, WS_MT) + (size_t)(b * 1024 + h * 256) * DM);
        pg8::EpiLnSoftmaxP E{pg8::EpiSoftmaxP{WSP(bf16_t, WS_XN), 1024, 0.04419417382415922f, tmax, tsum}, lntab, WSP(float, WS_CS2) + b * 1024, WSP(float, WS_CS2) + 4096 + b * 1024};
        pg8::gemm_phase(C.lds, C.tid, C.wave, pg8::Gemm{DM, DM, DM}, S, E); __syncthreads(); }
}
__device__ __forceinline__ void phase11(unsigned char* lds_raw, int wave_s) {
    const Ctx C = mk_ctx(lds_raw, wave_s); const ArgsP A = get_args(); unsigned char* ws = (unsigned char*)A->ws;
    pg8::BatchOrder S; S.init(WSP(bf16_t, WS_XN), WSP(bf16_t, WS_VWT), 1024, 1024, NT, DM, C.G, C.bx); S.bstride = (size_t)2048 * 1024 * 2;
    const int pm0 = pg8::ln_build_tables(WSP(f32x2, WS_ST1), S, C.tid, LNTAB);
    pg8::EpiResStats<1> E{nullptr, WSP(bf16_t, WS_ZB), WSP(f32x2, WS_ST2), LNTAB, pm0, AIN(I_LN1G), AIN(I_LN1B), ALPHA};
    int K = 1024; asm volatile("" : "+s"(K));
    pg8::gemm_phase(C.lds, C.tid, C.wave, pg8::Gemm{1024, 1024, K}, S, E);
}
__device__ __forceinline__ void phase14(unsigned char* lds_raw, int wave_s) {
    const Ctx C = mk_ctx(lds_raw, wave_s); const ArgsP A = get_args(); unsigned char* ws = (unsigned char*)A->ws;
    for (int un = C.gw; un < (NT / 32) * 8; un += C.NGW) peer::route_unit(C.lane, (un >> 3) * 32, un & 7, WSP(bf16_t, WS_PQ), WSP(bf16_t, WS_SK), WSP(int, WS_EXP), WSP(float, WS_PG), (LAS unsigned*)(C.lds + C.wave * 8192));
}
__device__ __forceinline__ void phase15(unsigned char* lds_raw, int wave_s, bool dummy = false) {
    const Ctx C = mk_ctx(lds_raw, wave_s); const ArgsP A = get_args(); unsigned char* ws = (unsigned char*)A->ws;
    for (int tok = C.gw; tok < NT; tok += C.NGW) peer::gather_token(C.lane, tok, WSP(f32x2, WS_ST2), AIN(I_LN2G), AIN(I_LN2B), WSP(bf16_t, WS_ZB), AOUT, WSP(unsigned char, WS_UB), WSP(unsigned char, WS_VB), WSP(float, WS_USC), WSP(float, WS_VSC), WSP(int, WS_EXP), WSP(float, WS_PG), AIN(I_LN3G), AIN(I_LN3B));
}

__device__ __forceinline__ void fwd_body(const int lo, const int hi, unsigned char* lds_raw) {
    const int wave_s = __builtin_amdgcn_readfirstlane((int)threadIdx.x >> 6);
    const bool multi = (hi - lo) > 1;
    volatile LAS unsigned* st = (volatile LAS unsigned*)((LAS unsigned char*)lds_raw + LDSCTL_OFF);
#define LEADER() (wave_s == 0 && lane_now() == 0u)

    XcdBarrier bar; bar.bar = nullptr; bar.x = 0; bar.st = st;
    if (multi) { if (LEADER()) { st[0] = 0u; st[1] = 0u; } __syncthreads(); bar = xcd_barrier_post((unsigned*)get_args()->ws + CW_BAR, st, LEADER()); }
#define IN(k) (lo <= (k) && (k) < hi)
#if MK_CG_SYNC
    cg::grid_group grid = cg::this_grid();
#define SEAM(k) do { if (multi && (k) + 1 < hi) { __syncthreads(); grid.sync(); } } while (0)
#else
#define SEAM(k) do { if (multi && (k) + 1 < hi) { xcd_barrier(bar, LEADER()); } } while (0)
#endif
    if (IN(0)) { phase0(lds_raw, wave_s); if (DUP(0)) phase0(lds_raw, wave_s); SEAM(0); }
    if (IN(1)) { phase1(lds_raw, wave_s); if (DUP(1)) phase1(lds_raw, wave_s); SEAM(1); }
    if (IN(3)) { phase3a(lds_raw, wave_s); if (DUP(16)) phase3a(lds_raw, wave_s); phase3b(lds_raw, wave_s); if (DUP(17)) phase3b(lds_raw, wave_s); SEAM(3); }
    if (IN(4)) { phase4(lds_raw, wave_s); if (DUP(4)) phase4(lds_raw, wave_s); SEAM(4); }
    if (IN(5)) { phase5(lds_raw, wave_s); if (DUP(5)) phase5(lds_raw, wave_s); SEAM(5); }
    if (IN(7)) { phase_scores(lds_raw, wave_s); if (DUP(7)) phase_scores(lds_raw, wave_s); SEAM(7); }
    if (IN(11)) { phase11(lds_raw, wave_s); SEAM(11); }
    if (IN(13)) { phase_lnfold(lds_raw, wave_s, WS_PWQ, WS_PQ, WS_ST2, WS_CS + 16384); SEAM(13); }
    if (IN(14)) { phase14(lds_raw, wave_s); if (DUP(14)) phase14(lds_raw, wave_s); SEAM(14); }
    if (IN(15)) { if (DUP(15)) phase15(lds_raw, wave_s, true); phase15(lds_raw, wave_s); }
#undef IN
#undef SEAM
}
#if MK_ONE_LAUNCH
__global__ void __launch_bounds__(NTHREADS, 2) fwd_kernel(Args args) {
    extern __shared__ __attribute__((aligned(16))) unsigned char lds_dyn[];
    fwd_body(args.ph_lo, args.ph_hi, lds_dyn);
}
#endif
#if !MK_ONE_LAUNCH
template <int PH> __global__ void __launch_bounds__(NTHREADS, 2) phase_kernel(Args args) {
    extern __shared__ __attribute__((aligned(16))) unsigned char lds_dyn[];
    fwd_body(PH, PH + 1, lds_dyn);
}

#endif
#if MK_ONE_LAUNCH
#define OCC_FN ((const void*)fwd_kernel)
#else
#define OCC_FN phase_fn(3)
static const void* phase_fn(int ph) {
    switch (ph) {
        case 0: return (const void*)phase_kernel<0>; case 1: return (const void*)phase_kernel<1>; case 2: return (const void*)phase_kernel<2>; case 3: return (const void*)phase_kernel<3>;
        case 4: return (const void*)phase_kernel<4>; case 5: return (const void*)phase_kernel<5>; case 6: return (const void*)phase_kernel<6>; case 7: return (const void*)phase_kernel<7>;
        case 8: return (const void*)phase_kernel<8>; case 9: return (const void*)phase_kernel<9>; case 10: return (const void*)phase_kernel<10>; case 11: return (const void*)phase_kernel<11>;
        case 12: return (const void*)phase_kernel<12>; case 13: return (const void*)phase_kernel<13>; case 14: return (const void*)phase_kernel<14>; default: return (const void*)phase_kernel<15>;
    }
}
#endif
extern "C" void kernel_launch(void* const* d_in, const int* in_sizes, int n_in, void* d_out, int out_size, void* d_ws, size_t ws_size, hipStream_t stream) {
    static int grid = 0;
    if (grid == 0) {
        if (n_in != 23 || in_sizes[0] != NT * DM || out_size != NT * DM || ws_size < WS_END) {
            fprintf(stderr, "kernel_launch: built for 23 inputs, x/out of %d floats, >= %zu bytes of workspace; got n_in %d, in0 %d, out %d, ws %zu\n", NT * DM, (size_t)WS_END, n_in, n_in > 0 ? in_sizes[0] : -1, out_size, ws_size);
            grid = -1; return; }
        int dev = 0, cus = 0, per_cu = 0;
        if (hipGetDevice(&dev) != hipSuccess || hipDeviceGetAttribute(&cus, hipDeviceAttributeMultiprocessorCount, dev) != hipSuccess) { grid = -1; return; }
#if MK_ONE_LAUNCH
        if (hipFuncSetAttribute((const void*)fwd_kernel, hipFuncAttributeMaxDynamicSharedMemorySize, LDS_BYTES) != hipSuccess) { fprintf(stderr, "kernel_launch: hipFuncSetAttribute failed\n"); grid = -1; return; }
#else
        for (int ph = 0; ph < NPH; ++ph) if (hipFuncSetAttribute(phase_fn(ph), hipFuncAttributeMaxDynamicSharedMemorySize, LDS_BYTES) != hipSuccess) { fprintf(stderr, "kernel_launch: hipFuncSetAttribute failed\n"); grid = -1; return; }
#endif
        if (hipOccupancyMaxActiveBlocksPerMultiprocessor(&per_cu, OCC_FN, NTHREADS, LDS_BYTES) != hipSuccess || per_cu < 1) {
            fprintf(stderr, "kernel_launch: occupancy query reports %d workgroups per CU\n", per_cu); (void)hipGetLastError(); }
        grid = cus;
        if (grid != 256) fprintf(stderr, "kernel_launch: %d CUs (tuned for 256)\n", grid);
    }
    if (grid < 0) return;
    (void)hipMemsetAsync((char*)d_ws + WS_CTL, 0, CTL_ZERO_BYTES, stream);
    Args a{};
    for (int i = 0; i < 23; ++i) a.in[i] = (GAS const float*)d_in[i];
    a.out = (GAS float*)d_out; a.ws = (GAS unsigned char*)d_ws;
#if MK_ONE_LAUNCH
    a.ph_lo = 0; a.ph_hi = NPH;
    void* kargs[] = {&a};
    hipError_t e = hipLaunchCooperativeKernel((const void*)fwd_kernel, dim3(grid), dim3(NTHREADS), kargs, LDS_BYTES, stream);
    if (e != hipSuccess) fprintf(stderr, "kernel_launch: cooperative launch failed: %s (grid %d)\n", hipGetErrorString(e), grid);
#else
    for (int ph = 0; ph < NPH; ++ph) {
        a.ph_lo = ph; a.ph_hi = ph + 1;
        void* kargs[] = {&a};
        (void)hipLaunchKernel(phase_fn(ph), dim3(grid), dim3(NTHREADS), kargs, LDS_BYTES, stream);
    }
    const hipError_t le = hipPeekAtLastError();
    if (le != hipSuccess) fprintf(stderr, "kernel_launch: launch failed: %s\n", hipGetErrorName(le));
#endif
}
```

```cpp
#include <hip/hip_runtime.h>
#include <hip/hip_bf16.h>
#include <hip/hip_cooperative_groups.h>
#include <cstdio>
#include <cstdint>
namespace cg = cooperative_groups;

#define GAS __attribute__((address_space(1)))
#define LAS __attribute__((address_space(3)))
typedef unsigned short bf16_t;
typedef short bf16x8 __attribute__((ext_vector_type(8)));
typedef short s16x4 __attribute__((ext_vector_type(4)));
typedef float f32x4 __attribute__((ext_vector_type(4)));
typedef float f32x2 __attribute__((ext_vector_type(2)));
typedef float f32x16 __attribute__((ext_vector_type(16)));
typedef unsigned u32x4 __attribute__((ext_vector_type(4)));
typedef unsigned u32x2 __attribute__((ext_vector_type(2)));

constexpr int NB = 4, SEQ = 4096, DM = 2048, NT = NB * SEQ;
constexpr int MEML = 256, NMEM = NB * MEML;
constexpr int IN_TOTAL = 4624, HP = 4608, NPAD = 4864;
constexpr int C_AQ = 0, C_AK = 1024, C_AV = 1280, C_MQ = 1536, C_MK = 2048, C_MV = 2560, C_MO = 3584, C_G = 4608;
constexpr int NEXP = 16384;
constexpr float ALPHA = 1.189207115002721f;
constexpr float LN_EPS = 1e-5f, RMS_EPS = 1e-6f;
constexpr int NWAVES = 8, NTHREADS = 512;

constexpr size_t MiB = 1u << 20;
constexpr size_t WS_CTL = 0, CTL_ZERO_BYTES = 65536;
constexpr size_t WS_WIN = 2 * MiB;
constexpr size_t WS_WOUT = 22 * MiB, WS_XWQ = 30 * MiB, WS_XWK = 38 * MiB, WS_XWV = 46 * MiB, WS_XWO = 54 * MiB, WS_PWQ = 62 * MiB;
constexpr size_t WS_SK = 70 * MiB;
constexpr size_t WS_MEMB = 71 * MiB;
constexpr size_t WS_K2 = 75 * MiB;
constexpr size_t WS_V2T = 79 * MiB;
constexpr size_t WS_GATES = 83 * MiB;
constexpr size_t WS_EXP = 84 * MiB, WS_PG = 92 * MiB;
constexpr size_t WS_XN = 100 * MiB;
constexpr size_t WS_H = 164 * MiB;
constexpr size_t WS_ZB = WS_H, WS_Q2 = WS_H + 64 * MiB, WS_O2 = WS_H + 64 * MiB, WS_PQ = WS_H + 64 * MiB;
constexpr size_t WS_ST1 = 330 * MiB, WS_ST2 = 336 * MiB;
constexpr size_t WS_CS = 32768;
constexpr size_t WS_CSP = 342 * MiB;
constexpr size_t WS_UB = 308 * MiB, WS_VB = 372 * MiB;
constexpr size_t WS_USC = 1 * MiB, WS_VSC = 1 * MiB + 65536;
constexpr size_t WS_WQN = 400 * MiB;
constexpr size_t WS_MT = 408 * MiB;
constexpr size_t WS_VWT = 424 * MiB;
constexpr size_t WS_CS2 = 1 * MiB + 262144;
constexpr size_t WS_CC = 448 * MiB;
constexpr size_t WS_END = 512 * MiB;
constexpr int CW_BAR = 4096;

constexpr int RING_BYTES = 131072;
constexpr int LDSCTL_OFF = 143360;
constexpr int LDS_BYTES = 155648;

#define LDS_WAIT() asm volatile("s_waitcnt lgkmcnt(0)" ::: "memory")
#define VM_WAIT() asm volatile("s_waitcnt vmcnt(0)" ::: "memory")
#define SBAR() __builtin_amdgcn_sched_barrier(0)
__device__ __forceinline__ unsigned f2bf(float f) { unsigned u = __builtin_bit_cast(unsigned, f); return (u + 0x7fffu + ((u >> 16) & 1u)) >> 16; }
__device__ __forceinline__ float bf2f(unsigned short h) { return __builtin_bit_cast(float, (unsigned)h << 16); }
__device__ __forceinline__ float bflo(unsigned w) { return __builtin_bit_cast(float, w << 16); }
__device__ __forceinline__ float bfhi(unsigned w) { return __builtin_bit_cast(float, w & 0xffff0000u); }
typedef __bf16 bf16x2_t __attribute__((ext_vector_type(2)));
__device__ __forceinline__ unsigned cvt_pk_bf16(float lo, float hi) { const f32x2 v = {lo, hi}; return __builtin_bit_cast(unsigned, __builtin_convertvector(v, bf16x2_t)); }
__device__ __forceinline__ unsigned pk2(float lo, float hi) { return cvt_pk_bf16(lo, hi); }
__device__ __forceinline__ float wave_sum(float v) {
#pragma unroll
    for (int o = 1; o < 64; o <<= 1) v += __shfl_xor(v, o);
    return v;
}
__device__ __forceinline__ float wave_max(float v) {
#pragma unroll
    for (int o = 1; o < 64; o <<= 1) v = fmaxf(v, __shfl_xor(v, o));
    return v;
}
__device__ __forceinline__ int crow(int r, int hi) { return (r & 3) + 8 * (r >> 2) + 4 * hi; }

#define XB_TMO      128
#define XB_XCNT(j)  (256  + 64 * (j))
#define XB_XSUB(j)  (1280 + 64 * (j))
#define XB_XGEN(j)  (2304 + 64 * (j))
#define XB_TOP      3328
#define XB_TOPGEN   3392
#define XCD_BAR_WORDS 3456
#define XB_SPIN_CAP (1u << 20)
__device__ __forceinline__ unsigned xb_ld(unsigned* p)              { return __hip_atomic_load((GAS unsigned*)p, __ATOMIC_RELAXED, __HIP_MEMORY_SCOPE_AGENT); }
__device__ __forceinline__ unsigned xb_add(unsigned* p, unsigned v) { return __hip_atomic_fetch_add((GAS unsigned*)p, v, __ATOMIC_RELAXED, __HIP_MEMORY_SCOPE_AGENT); }
__device__ __forceinline__ unsigned xb_xcc_id() { return (unsigned)__builtin_amdgcn_s_getreg((3 << 11) | 20) & 0xFu; }
#define XB_SPIN(cond, bar) do { unsigned _sp = 0; while (cond) { __builtin_amdgcn_s_sleep(1); \
    if ((++_sp & 255u) == 0u) { if (xb_ld(&(bar)[XB_TMO])) break; if (_sp > XB_SPIN_CAP) { (void)xb_add(&(bar)[XB_TMO], 1u); break; } } } } while (0)
struct XcdBarrier { unsigned* bar; unsigned x; volatile LAS unsigned* st; };
__device__ __forceinline__ XcdBarrier xcd_barrier_post(unsigned* bar, volatile LAS unsigned* st, bool leader) {
    XcdBarrier b; b.bar = bar; b.x = xb_xcc_id(); b.st = st;
    if (leader) (void)xb_add(&bar[XB_XCNT(b.x)], 1u);
    return b;
}
__device__ __forceinline__ void xcd_barrier_complete(unsigned* bar, unsigned x, unsigned& nloc, unsigned& nx) {
    const unsigned G = gridDim.x * gridDim.y * gridDim.z;
    unsigned sum, cnt, mine, sp = 0u;
    for (;;) {
        sum = 0u; cnt = 0u; mine = 0u;
#pragma unroll
        for (unsigned j = 0; j < 16; ++j) { const unsigned c = xb_ld(&bar[XB_XCNT(j)]); sum += c; cnt += (c > 0u) ? 1u : 0u; mine = (j == x) ? c : mine; }
        if (sum == G) break;
        __builtin_amdgcn_s_sleep(1);
        if ((++sp & 255u) == 0u) { if (xb_ld(&bar[XB_TMO])) break; if (sp > XB_SPIN_CAP) { (void)xb_add(&bar[XB_TMO], 1u); break; } }
    }
    nloc = mine > 0u ? mine : 1u; nx = cnt > 0u ? cnt : 1u;
}
__device__ __forceinline__ void xcd_barrier(const XcdBarrier& b, bool leader) {
    asm volatile("s_waitcnt vmcnt(0)" ::: "memory");
    __syncthreads();
    if (leader) {
        unsigned* bar = b.bar;
        __builtin_amdgcn_s_waitcnt(0);
        unsigned nloc = b.st[0], nx = b.st[1];
        if (nloc == 0u) { xcd_barrier_complete(bar, b.x, nloc, nx); b.st[0] = nloc; b.st[1] = nx; }
        const unsigned old = xb_add(&bar[XB_XSUB(b.x)], 1u);
        const unsigned gen = old / nloc;
        if (old + 1u == (gen + 1u) * nloc) {
            __builtin_amdgcn_fence(__ATOMIC_RELEASE, "agent");
            asm volatile("s_waitcnt vmcnt(0)" ::: "memory");
            const unsigned og = xb_add(&bar[XB_TOP], 1u);
            const unsigned tg = og / nx;
            if (og + 1u == (tg + 1u) * nx) xb_add(&bar[XB_TOPGEN], 1u);
            else XB_SPIN(xb_ld(&bar[XB_TOPGEN]) == tg, bar);
            __builtin_amdgcn_fence(__ATOMIC_ACQUIRE, "agent");
            xb_add(&bar[XB_XGEN(b.x)], 1u);
            asm volatile("s_waitcnt vmcnt(0)" ::: "memory");
        } else {
            XB_SPIN(xb_ld(&bar[XB_XGEN(b.x)]) == gen, bar);
            __builtin_amdgcn_fence(__ATOMIC_ACQUIRE, "agent");
            asm volatile("s_waitcnt vmcnt(0)" ::: "memory");
        }
    }
    __syncthreads();
}

__device__ __forceinline__ void ctr_barrier(unsigned* cnt, unsigned target, bool leader) {
    asm volatile("s_waitcnt vmcnt(0)" ::: "memory");
    __syncthreads();
    if (leader) {
        __builtin_amdgcn_fence(__ATOMIC_RELEASE, "agent");
        asm volatile("s_waitcnt vmcnt(0)" ::: "memory");
        (void)xb_add(cnt, 1u);
        unsigned sp = 0u;
        while (xb_ld(cnt) < target) { __builtin_amdgcn_s_sleep(2); if (++sp > (1u << 24)) break; }
        __builtin_amdgcn_fence(__ATOMIC_ACQUIRE, "agent");
        asm volatile("s_waitcnt vmcnt(0)" ::: "memory");
    }
    __syncthreads();
}

namespace pg8 {
constexpr int BM = 256, BK = 64, HALF = 128, HTB = HALF * BK * 2, STAGE_BYTES = 8 * HTB, NXCD = 8, WGM = 8;
__host__ __device__ __forceinline__ int lds_byte(int r, int c) { const int st = (r >> 4) * 2 + (c >> 5), rr = r & 15, cc = c & 31, ob = rr * 64 + cc * 2; return st * 1024 + (ob ^ (((ob >> 9) & 1) << 5)); }
__host__ __device__ __forceinline__ void stage_rc(int b, int& R, int& C) { const int st = b / 1024, sb = b % 1024, swz = sb ^ (((sb >> 9) & 1) << 5); R = (st >> 1) * 16 + swz / 64; C = (st & 1) * 32 + (swz % 64) / 2; }
__host__ __device__ __forceinline__ int perm32(int rho) { const int n = rho >> 4, i = rho & 15; return 8 * (i >> 2) + 4 * n + (i & 3); }

struct Unit { int pm, pn; const char* a; const char* b; };
struct Gemm { int lda, ldb, K; };

struct PlainOrder {
    const bf16_t* A; const bf16_t* Bt; int lda, ldb; int nM, nN, nwg, G, c, c0;
    __device__ void init(const bf16_t* A_, const bf16_t* Bt_, int lda_, int ldb_, int M, int N, int G_, int c_, int c0_ = 0) { A = A_; Bt = Bt_; lda = lda_; ldb = ldb_; nM = M / BM; nN = N / BM; nwg = nM * nN; G = G_; c = c_; c0 = c0_; }
    __device__ bool next(int i, Unit& u) const {
        const int cc = c - c0; if (cc < 0) return false;
        const long L = (long)i * G + cc; if (L >= nwg) return false;
        int wgid = (int)L; { const int q = nwg / NXCD, r = nwg % NXCD, xcd = wgid % NXCD, off = wgid / NXCD; wgid = (xcd < r ? xcd * (q + 1) : r * (q + 1) + (xcd - r) * q) + off; }
        const int nig = WGM * nN, gid = wgid / nig, fm = gid * WGM, gsz = (nM - fm) < WGM ? (nM - fm) : WGM;
        u.pm = fm + ((wgid % nig) % gsz); u.pn = (wgid % nig) / gsz;
        u.a = (const char*)(A + (size_t)u.pm * BM * lda); u.b = (const char*)(Bt + (size_t)u.pn * BM * ldb); return true;
    }
};

template <class Epi, class Sched>
__device__ __forceinline__ void gemm_phase(LAS unsigned char* lds, const int tid, const int wid, const Gemm g, const Sched& S, const Epi& E) {
    const int lane = tid & 63, wr = wid >> 2, wc = wid & 3, fr = lane & 15, fq = lane >> 4;
    const int K = g.K, nt = K / BK;
    unsigned voffA[2], voffB[2];
#pragma unroll
    for (int i = 0; i < 2; ++i) { int R, C; stage_rc(tid * 16 + i * 8192, R, C); const int Rb = Epi::PERM ? ((R & ~31) + perm32(R & 31)) : R;
        voffA[i] = (unsigned)(R * g.lda + C) * 2u; voffB[i] = (unsigned)(Rb * g.ldb + C) * 2u; }
    const size_t kstep = (size_t)(BK * 2);
    const size_t hsA = (size_t)HALF * g.lda * 2, hsB = (size_t)HALF * g.ldb * 2;
    const unsigned ldsw = (unsigned)wid * 1024u;
    const int aoff = lds_byte(wr * 64 + fr, fq * 8), boff = lds_byte(wc * 32 + fr, fq * 8);
#define PG8_SA(b, h) (((b) * 2 + (h)) * HTB)
#define PG8_SB(b, h) ((4 + (b) * 2 + (h)) * HTB)
#define PG8_STAGE(bufoff, gbase, voff) do { _Pragma("unroll") for (int _i = 0; _i < 2; ++_i) \
        __builtin_amdgcn_global_load_lds((const unsigned*)((const char*)(gbase) + (voff)[_i]), (LAS unsigned*)(lds + (bufoff) + ldsw + _i * 8192), 16, 0, 0); } while (0)
#define PG8_LDA(dst, b, h) do { _Pragma("unroll") for (int m = 0; m < 4; ++m) _Pragma("unroll") for (int k = 0; k < 2; ++k) dst[m][k] = *(const LAS bf16x8*)(lds + PG8_SA(b, h) + aoff + m * 2048 + k * 1024); } while (0)
#define PG8_LDB(dst, b, h) do { _Pragma("unroll") for (int n = 0; n < 2; ++n) _Pragma("unroll") for (int k = 0; k < 2; ++k) dst[n][k] = *(const LAS bf16x8*)(lds + PG8_SB(b, h) + boff + n * 2048 + k * 1024); } while (0)
#define PG8_MMA(ai, bj, At, Bt) do { __builtin_amdgcn_s_setprio(1); _Pragma("unroll") for (int m = 0; m < 4; ++m) _Pragma("unroll") for (int n = 0; n < 2; ++n) _Pragma("unroll") for (int k = 0; k < 2; ++k) \
        acc[ai][bj][m][n] = __builtin_amdgcn_mfma_f32_16x16x32_bf16(Bt[n][k], At[m][k], acc[ai][bj][m][n], 0, 0, 0); __builtin_amdgcn_s_setprio(0); } while (0)
#define PG8_WAIT_V(n) asm volatile("s_waitcnt vmcnt(" #n ")" ::: "memory")
#define PG8_WAIT_L(n) asm volatile("s_waitcnt lgkmcnt(" #n ")" ::: "memory")
#define PG8_BAR __builtin_amdgcn_s_barrier()
#define PG8_SCHED __builtin_amdgcn_sched_barrier(0)
    Unit cur, nxt; int ui = 0;
    if (!S.next(0, cur)) return;
    f32x4 acc[2][2][4][2];
#pragma unroll
    for (int a = 0; a < 2; ++a)
#pragma unroll
        for (int b = 0; b < 2; ++b)
#pragma unroll
            for (int m = 0; m < 4; ++m)
#pragma unroll
                for (int n = 0; n < 2; ++n) acc[a][b][m][n] = (f32x4){0.f, 0.f, 0.f, 0.f};
    bf16x8 At[4][2], B0[2][2], B1[2][2];
    const char* cA = cur.a; const char* cB = cur.b;
    PG8_STAGE(PG8_SB(0, 0), cB, voffB); PG8_STAGE(PG8_SB(0, 1), cB + hsB, voffB); PG8_STAGE(PG8_SA(0, 0), cA, voffA); PG8_STAGE(PG8_SA(0, 1), cA + hsA, voffA);
    if (wr == 1) PG8_BAR;
    PG8_WAIT_V(2); PG8_BAR;
    PG8_STAGE(PG8_SB(1, 0), cB + kstep, voffB); PG8_STAGE(PG8_SA(1, 0), cA + kstep, voffA); PG8_STAGE(PG8_SB(1, 1), cB + hsB + kstep, voffB);
    PG8_WAIT_V(6); PG8_BAR;
    for (;;) {
        const bool has_next = S.next(ui + 1, nxt);
        const char* nA = has_next ? nxt.a : cA; const char* nB = has_next ? nxt.b : cB;
        for (int t = 0; t < nt; t += 2) {
            const bool last = (t == nt - 2);
            const char* a1 = cA + (size_t)(t + 1) * kstep;
            const char* a2 = last ? nA : cA + (size_t)(t + 2) * kstep; const char* b2 = last ? nB : cB + (size_t)(t + 2) * kstep;
            const char* a3 = a2 + kstep; const char* b3 = b2 + kstep;
            PG8_LDB(B0, 0, 0); PG8_LDB(B1, 0, 1); PG8_SCHED; PG8_LDA(At, 0, 0); PG8_STAGE(PG8_SA(1, 1), a1 + hsA, voffA);
            PG8_WAIT_V(8); PG8_WAIT_L(0); PG8_BAR; PG8_MMA(0, 0, At, B0); PG8_MMA(0, 1, At, B1); PG8_BAR; PG8_SCHED;
            PG8_LDA(At, 0, 1); PG8_STAGE(PG8_SB(0, 0), b2, voffB); PG8_STAGE(PG8_SB(0, 1), b2 + hsB, voffB); PG8_STAGE(PG8_SA(0, 0), a2, voffA);
            PG8_WAIT_V(8); PG8_WAIT_L(0); PG8_BAR; PG8_MMA(1, 0, At, B0); PG8_MMA(1, 1, At, B1); PG8_BAR; PG8_SCHED;
            PG8_LDB(B0, 1, 0); PG8_LDB(B1, 1, 1); PG8_SCHED; PG8_LDA(At, 1, 0); PG8_STAGE(PG8_SA(0, 1), a2 + hsA, voffA);
            PG8_WAIT_V(8); PG8_WAIT_L(0); PG8_BAR; PG8_MMA(0, 0, At, B0); PG8_MMA(0, 1, At, B1); PG8_BAR; PG8_SCHED;
            PG8_LDA(At, 1, 1); PG8_STAGE(PG8_SB(1, 0), b3, voffB); PG8_STAGE(PG8_SB(1, 1), b3 + hsB, voffB); PG8_STAGE(PG8_SA(1, 0), a3, voffA);
            PG8_WAIT_V(8); PG8_WAIT_L(0); PG8_BAR; PG8_MMA(1, 0, At, B0); PG8_MMA(1, 1, At, B1); PG8_BAR; PG8_SCHED;
        }
        if (wr == 0) PG8_BAR;
        E(acc, cur, wr, wc, fr, fq);
        if (!has_next) break;
#pragma unroll
        for (int a = 0; a < 2; ++a)
#pragma unroll
            for (int b = 0; b < 2; ++b)
#pragma unroll
                for (int m = 0; m < 4; ++m)
#pragma unroll
                    for (int n = 0; n < 2; ++n) acc[a][b][m][n] = (f32x4){0.f, 0.f, 0.f, 0.f};
        cur = nxt; cA = nA; cB = nB; ++ui;
        if (wr == 1) PG8_BAR;
    }
    PG8_WAIT_V(0);
    PG8_BAR;
#undef PG8_SA
#undef PG8_SB
#undef PG8_STAGE
#undef PG8_LDA
#undef PG8_LDB
#undef PG8_MMA
#undef PG8_WAIT_V
#undef PG8_WAIT_L
#undef PG8_BAR
#undef PG8_SCHED
}

struct EpiBf16 {
    static constexpr bool PERM = true;
    bf16_t* O; int ldc; float scale;
    __device__ __forceinline__ void operator()(const f32x4 (&acc)[2][2][4][2], const Unit& u, int wr, int wc, int fr, int fq) const {
        const int row0 = u.pm * BM + wr * 64 + fr, col0 = u.pn * BM + wc * 32 + 8 * fq;
#pragma unroll
        for (int ai = 0; ai < 2; ++ai)
#pragma unroll
            for (int m = 0; m < 4; ++m) { bf16_t* rowp = O + (size_t)(row0 + ai * HALF + m * 16) * ldc + col0;
#pragma unroll
                for (int bj = 0; bj < 2; ++bj) { const f32x4 v0 = acc[ai][bj][m][0] * scale, v1 = acc[ai][bj][m][1] * scale;
                    u32x4 w; w.x = cvt_pk_bf16(v0[0], v0[1]); w.y = cvt_pk_bf16(v0[2], v0[3]); w.z = cvt_pk_bf16(v1[0], v1[1]); w.w = cvt_pk_bf16(v1[2], v1[3]);
                    *(u32x4*)(rowp + bj * HALF) = w; } }
    }
};
struct EpiH {
    static constexpr bool PERM = true;
    bf16_t* H; float* gates;
    __device__ __forceinline__ void operator()(const f32x4 (&acc)[2][2][4][2], const Unit& u, int wr, int wc, int fr, int fq) const {
        const int row0 = u.pm * BM + wr * 64 + fr;
        if (u.pn < 18) {
            const int col0 = u.pn * BM + wc * 32 + 8 * fq;
#pragma unroll
            for (int ai = 0; ai < 2; ++ai)
#pragma unroll
                for (int m = 0; m < 4; ++m) { bf16_t* rowp = H + (size_t)(row0 + ai * HALF + m * 16) * HP + col0;
#pragma unroll
                    for (int bj = 0; bj < 2; ++bj) { const f32x4 v0 = acc[ai][bj][m][0], v1 = acc[ai][bj][m][1];
                        u32x4 w; w.x = cvt_pk_bf16(v0[0], v0[1]); w.y = cvt_pk_bf16(v0[2], v0[3]); w.z = cvt_pk_bf16(v1[0], v1[1]); w.w = cvt_pk_bf16(v1[2], v1[3]);
                        *(u32x4*)(rowp + bj * HALF) = w; } }
        } else if (wc == 0 && fq < 2) {
#pragma unroll
            for (int ai = 0; ai < 2; ++ai)
#pragma unroll
                for (int m = 0; m < 4; ++m) { float* rowp = gates + (size_t)(row0 + ai * HALF + m * 16) * 16 + 8 * fq;
                    *(f32x4*)(rowp) = acc[ai][0][m][0]; *(f32x4*)(rowp + 4) = acc[ai][0][m][1]; }
        }
    }
};
__device__ __forceinline__ void ln_build_table(const f32x2* __restrict__ ST, int pm, int tid, LAS f32x2* tab) {
    const int rl = tid >> 1, hf = tid & 1; const f32x2* p = ST + (size_t)(pm * BM + rl) * 32 + 16 * hf; float s = 0.f, q = 0.f;
#pragma unroll
    for (int j = 0; j < 16; ++j) { const f32x2 v = p[j]; s += v[0]; q += v[1]; }
    s += __shfl_xor(s, 1); q += __shfl_xor(q, 1);
    const float mean = s * (1.0f / DM); const float var = fmaxf(q * (1.0f / DM) - mean * mean, 0.f);
    if (hf == 0) tab[rl] = (f32x2){mean, 1.0f / sqrtf(var + LN_EPS)};
}
template <class Sched> __device__ __forceinline__ int ln_build_tables(const f32x2* __restrict__ ST, const Sched& S, int tid, LAS f32x2* tab) {
    Unit u; int pm0 = -1;
    if (S.next(0, u)) { pm0 = u.pm; ln_build_table(ST, u.pm, tid, tab); if (S.next(1, u)) ln_build_table(ST, u.pm, tid, tab + 256); }
    LDS_WAIT(); __syncthreads();
    return pm0;
}
template <int MODE> struct EpiResStats {
    static constexpr bool PERM = true;
    const float* base; bf16_t* zb; f32x2* stn; LAS const f32x2* tab; int pm0; const float* gain; const float* bias; float alpha;
    __device__ __forceinline__ void operator()(const f32x4 (&acc)[2][2][4][2], const Unit& u, int wr, int wc, int fr, int fq) const {
        const int row0 = u.pm * BM + wr * 64 + fr, col0 = u.pn * BM + wc * 32 + 8 * fq;
        f32x4 gg[2][2], bb[2][2];
        if (MODE == 1) {
#pragma unroll
            for (int bj = 0; bj < 2; ++bj)
#pragma unroll
                for (int n = 0; n < 2; ++n) { gg[bj][n] = *(const f32x4*)(gain + col0 + bj * HALF + 4 * n); bb[bj][n] = *(const f32x4*)(bias + col0 + bj * HALF + 4 * n); } }
        constexpr int NS = (MODE == 2) ? 8 : 3;
        u32x4 zin[NS][2]; f32x4 xin[MODE == 0 ? NS : 1][2][2];
#define ERS_LOAD(IT, SLOT) do { const int ai_ = (IT) >> 2, m_ = (IT) & 3; const size_t off_ = (size_t)(row0 + ai_ * HALF + m_ * 16) * DM + col0; \
            _Pragma("unroll") for (int bj = 0; bj < 2; ++bj) { if (MODE == 1) zin[SLOT][bj] = *(const u32x4*)(zb + off_ + bj * HALF); else if (MODE == 2) zin[SLOT][bj] = *(const u32x4*)((const bf16_t*)base + off_ + bj * HALF); \
                else { xin[SLOT][bj][0] = *(const f32x4*)(base + off_ + bj * HALF); xin[SLOT][bj][1] = *(const f32x4*)(base + off_ + bj * HALF + 4); } } } while (0)
#pragma unroll
        for (int i0_ = 0; i0_ < NS - 1; ++i0_) ERS_LOAD(i0_, i0_);
#pragma unroll
        for (int it = 0; it < 8; ++it) { const int ai = it >> 2, m = it & 3, sl = it % NS;
            if (it + NS - 1 < 8) ERS_LOAD(it + NS - 1, (it + NS - 1) % NS);
            const int row = row0 + ai * HALF + m * 16; const size_t off = (size_t)row * DM + col0;
            f32x2 st = {0.f, 1.f}; if (MODE == 1) st = tab[(u.pm == pm0 ? 0 : 256) + ai * HALF + wr * 64 + m * 16 + fr];
            float s = 0.f, q = 0.f;
#pragma unroll
            for (int bj = 0; bj < 2; ++bj) { f32x4 o[2];
                if (MODE == 1) { const u32x4 zo = zin[sl][bj];
                    const f32x4 z0 = {bflo(zo[0]), bfhi(zo[0]), bflo(zo[1]), bfhi(zo[1])}, z1 = {bflo(zo[2]), bfhi(zo[2]), bflo(zo[3]), bfhi(zo[3])};
                    o[0] = ((z0 - st[0]) * st[1] * gg[bj][0] + bb[bj][0]) * alpha + acc[ai][bj][m][0]; o[1] = ((z1 - st[0]) * st[1] * gg[bj][1] + bb[bj][1]) * alpha + acc[ai][bj][m][1];
                } else if (MODE == 2) { const u32x4 zo = zin[sl][bj];
                    const f32x4 z0 = {bflo(zo[0]), bfhi(zo[0]), bflo(zo[1]), bfhi(zo[1])}, z1 = {bflo(zo[2]), bfhi(zo[2]), bflo(zo[3]), bfhi(zo[3])};
                    o[0] = z0 * alpha + acc[ai][bj][m][0]; o[1] = z1 * alpha + acc[ai][bj][m][1];
                } else {
                    o[0] = xin[sl][bj][0] * alpha + acc[ai][bj][m][0]; o[1] = xin[sl][bj][1] * alpha + acc[ai][bj][m][1]; }
#pragma unroll
                for (int n = 0; n < 2; ++n) { s += (o[n][0] + o[n][1]) + (o[n][2] + o[n][3]); q += (o[n][0] * o[n][0] + o[n][1] * o[n][1]) + (o[n][2] * o[n][2] + o[n][3] * o[n][3]); }
                u32x4 w; w.x = cvt_pk_bf16(o[0][0], o[0][1]); w.y = cvt_pk_bf16(o[0][2], o[0][3]); w.z = cvt_pk_bf16(o[1][0], o[1][1]); w.w = cvt_pk_bf16(o[1][2], o[1][3]);
                *(u32x4*)(zb + off + bj * HALF) = w; }
            s += __shfl_xor(s, 16); s += __shfl_xor(s, 32); q += __shfl_xor(q, 16); q += __shfl_xor(q, 32);
            if (fq == 0) stn[(size_t)row * 32 + 4 * u.pn + wc] = (f32x2){s, q}; }
#undef ERS_LOAD
    }
};
struct EpiLnFold {
    static constexpr bool PERM = true;
    bf16_t* O; int ldc; LAS const f32x2* tab; int pm0; const float* colsum; const float* bw;
    __device__ __forceinline__ void operator()(const f32x4 (&acc)[2][2][4][2], const Unit& u, int wr, int wc, int fr, int fq) const {
        const int row0 = u.pm * BM + wr * 64 + fr, col0 = u.pn * BM + wc * 32 + 8 * fq;
        f32x4 cs[2][2], bb[2][2];
#pragma unroll
        for (int bj = 0; bj < 2; ++bj)
#pragma unroll
            for (int n = 0; n < 2; ++n) { cs[bj][n] = *(const f32x4*)(colsum + col0 + bj * HALF + 4 * n); bb[bj][n] = *(const f32x4*)(bw + col0 + bj * HALF + 4 * n); }
#pragma unroll
        for (int ai = 0; ai < 2; ++ai)
#pragma unroll
            for (int m = 0; m < 4; ++m) { const int row = row0 + ai * HALF + m * 16; bf16_t* rowp = O + (size_t)row * ldc + col0; const f32x2 s = tab[(u.pm == pm0 ? 0 : 256) + ai * HALF + wr * 64 + m * 16 + fr];
#pragma unroll
                for (int bj = 0; bj < 2; ++bj) { const f32x4 v0 = (acc[ai][bj][m][0] - cs[bj][0] * s[0]) * s[1] + bb[bj][0], v1 = (acc[ai][bj][m][1] - cs[bj][1] * s[0]) * s[1] + bb[bj][1];
                    u32x4 w; w.x = cvt_pk_bf16(v0[0], v0[1]); w.y = cvt_pk_bf16(v0[2], v0[3]); w.z = cvt_pk_bf16(v1[0], v1[1]); w.w = cvt_pk_bf16(v1[2], v1[3]);
                    *(u32x4*)(rowp + bj * HALF) = w; } }
    }
};
struct EpiSoftmaxP {
    static constexpr bool PERM = true;
    bf16_t* P; int ldc; float scale; LAS float* tmax; LAS float* tsum;
    __device__ __forceinline__ void operator()(f32x4 (&acc)[2][2][4][2], const Unit& u, int wr, int wc, int fr, int fq) const {
        int fro = fr; asm volatile("" : "+v"(fro));
        const int row0 = u.pm * BM + wr * 64 + fro, col0 = u.pn * BM + wc * 32 + 8 * fq;
        float mx[2][4];
#pragma unroll
        for (int ai = 0; ai < 2; ++ai)
#pragma unroll
            for (int m = 0; m < 4; ++m) { float v = -__builtin_inff();
#pragma unroll
                for (int bj = 0; bj < 2; ++bj)
#pragma unroll
                    for (int n = 0; n < 2; ++n) { const f32x4 x = acc[ai][bj][m][n]; v = fmaxf(v, fmaxf(fmaxf(x[0], x[1]), fmaxf(x[2], x[3]))); }
                v = fmaxf(v, __shfl_xor(v, 16)); v = fmaxf(v, __shfl_xor(v, 32)); mx[ai][m] = v;
                if (fq == 0) tmax[(ai * HALF + wr * 64 + m * 16 + fro) * 4 + wc] = v; }
        LDS_WAIT(); __builtin_amdgcn_s_barrier(); asm volatile("" ::: "memory");
#pragma unroll
        for (int ai = 0; ai < 2; ++ai)
#pragma unroll
            for (int m = 0; m < 4; ++m) { const f32x4 pm4 = *(const LAS f32x4*)(tmax + (ai * HALF + wr * 64 + m * 16 + fro) * 4);
                const float rm = fmaxf(fmaxf(pm4[0], pm4[1]), fmaxf(pm4[2], pm4[3])) * scale; float s = 0.f;
#pragma unroll
                for (int bj = 0; bj < 2; ++bj)
#pragma unroll
                    for (int n = 0; n < 2; ++n) { f32x4 x = acc[ai][bj][m][n];
#pragma unroll
                        for (int j = 0; j < 4; ++j) { x[j] = __expf(x[j] * scale - rm); s += x[j]; }
                        acc[ai][bj][m][n] = x; }
                s += __shfl_xor(s, 16); s += __shfl_xor(s, 32);
                if (fq == 0) tsum[(ai * HALF + wr * 64 + m * 16 + fro) * 4 + wc] = s; }
        LDS_WAIT(); __builtin_amdgcn_s_barrier(); asm volatile("" ::: "memory");
#pragma unroll
        for (int ai = 0; ai < 2; ++ai)
#pragma unroll
            for (int m = 0; m < 4; ++m) { const f32x4 ps4 = *(const LAS f32x4*)(tsum + (ai * HALF + wr * 64 + m * 16 + fro) * 4);
                const float inv = 1.0f / ((ps4[0] + ps4[1]) + (ps4[2] + ps4[3])); bf16_t* rowp = P + (size_t)(row0 + ai * HALF + m * 16) * ldc + col0;
#pragma unroll
                for (int bj = 0; bj < 2; ++bj) { const f32x4 v0 = acc[ai][bj][m][0] * inv, v1 = acc[ai][bj][m][1] * inv;
                    u32x4 w; w.x = cvt_pk_bf16(v0[0], v0[1]); w.y = cvt_pk_bf16(v0[2], v0[3]); w.z = cvt_pk_bf16(v1[0], v1[1]); w.w = cvt_pk_bf16(v1[2], v1[3]);
                    *(u32x4*)(rowp + bj * HALF) = w; } }
    }
};
struct EpiLnSoftmaxP {
    static constexpr bool PERM = true;
    EpiSoftmaxP sm; LAS const f32x2* tab; const float* cs; const float* bw;
    __device__ __forceinline__ void operator()(f32x4 (&acc)[2][2][4][2], const Unit& u, int wr, int wc, int fr, int fq) const {
        int fro = fr; asm volatile("" : "+v"(fro));
        const int col0 = u.pn * BM + wc * 32 + 8 * fq;
#pragma unroll
        for (int bj = 0; bj < 2; ++bj)
#pragma unroll
            for (int n = 0; n < 2; ++n) { const f32x4 c4 = *(const f32x4*)(cs + col0 + bj * HALF + 4 * n), b4 = *(const f32x4*)(bw + col0 + bj * HALF + 4 * n);
#pragma unroll
                for (int ai = 0; ai < 2; ++ai)
#pragma unroll
                    for (int m = 0; m < 4; ++m) { const f32x2 st = tab[ai * HALF + wr * 64 + m * 16 + fro]; acc[ai][bj][m][n] = (acc[ai][bj][m][n] - c4 * st[0]) * st[1] + b4; } }
        sm(acc, u, wr, wc, fr, fq);
    }
};
struct BatchOrder : PlainOrder {
    size_t bstride;
    __device__ bool next(int i, Unit& u) const { if (!PlainOrder::next(i, u)) return false; u.b += (size_t)(u.pm >> 4) * bstride; return true; }
};
struct EpiF32 {
    static constexpr bool PERM = false;
    float* C; int ldc; float scale;
    __device__ __forceinline__ void operator()(const f32x4 (&acc)[2][2][4][2], const Unit& u, int wr, int wc, int fr, int fq) const {
        const int row0 = u.pm * BM + wr * 64 + fr, col0 = u.pn * BM + wc * 32 + 4 * fq;
#pragma unroll
        for (int ai = 0; ai < 2; ++ai)
#pragma unroll
            for (int m = 0; m < 4; ++m) { float* rowp = C + (size_t)(row0 + ai * HALF + m * 16) * ldc + col0;
#pragma unroll
                for (int bj = 0; bj < 2; ++bj)
#pragma unroll
                    for (int n = 0; n < 2; ++n) *(f32x4*)(rowp + bj * HALF + n * 16) = acc[ai][bj][m][n] * scale; }
    }
};
}

struct Ctx { LAS unsigned char* lds; int tid, lane, wave, vcu, G, gw, NGW, bx; };

__device__ __forceinline__ void p0_transpose_item(const float* W, int K, int N, bf16_t* WT, LAS float* scr, int item, int nblk, int lane,
                                                  const float* gvec = nullptr, const float* bvec = nullptr, float* colsum = nullptr, float* bw = nullptr, bf16_t* WN = nullptr) {
    const int kb = item / nblk, nb = item % nblk, k0 = 64 * kb, n0 = 32 * nb;
    const int nn = n0 + (lane & 31);
    float pcs = 0.f, pbw = 0.f; float wv[32];
#pragma unroll
    for (int i = 0; i < 32; ++i) { const int kk = 2 * i + (lane >> 5); wv[i] = (nn < N) ? __builtin_nontemporal_load(W + (size_t)(k0 + kk) * N + nn) : 0.f; }
#pragma unroll
    for (int i = 0; i < 32; ++i) { const int kk = 2 * i + (lane >> 5); float w = wv[i];
        if (gvec) { pbw += w * bvec[k0 + kk]; w *= gvec[k0 + kk]; pcs += w; }
        scr[kk * 33 + (lane & 31)] = w; }
    if (gvec) { pcs += __shfl_xor(pcs, 32); pbw += __shfl_xor(pbw, 32); if (lane < 32) { colsum[(size_t)kb * 2048 + nn] = pcs; bw[(size_t)kb * 2048 + nn] = pbw; } }
    LDS_WAIT(); asm volatile("" ::: "memory");
    if (WN) {
        const LAS float* rp = scr + lane * 33;
#pragma unroll
        for (int q = 0; q < 4; ++q) { u32x4 o; o.x = pk2(rp[8 * q], rp[8 * q + 1]); o.y = pk2(rp[8 * q + 2], rp[8 * q + 3]); o.z = pk2(rp[8 * q + 4], rp[8 * q + 5]); o.w = pk2(rp[8 * q + 6], rp[8 * q + 7]);
            *(u32x4*)(WN + (size_t)(k0 + lane) * N + n0 + 8 * q) = o; }
        LDS_WAIT(); asm volatile("" ::: "memory");
        return; }
    const int c = lane & 7;
#pragma unroll
    for (int j = 0; j < 4; ++j) { const int n = (lane >> 3) + 8 * j; const LAS float* s = scr + (8 * c) * 33 + n;
        u32x4 o; o.x = pk2(s[0 * 33], s[1 * 33]); o.y = pk2(s[2 * 33], s[3 * 33]); o.z = pk2(s[4 * 33], s[5 * 33]); o.w = pk2(s[6 * 33], s[7 * 33]);
        *(u32x4*)(WT + (size_t)(n0 + n) * K + k0 + 8 * c) = o; }
    LDS_WAIT(); asm volatile("" ::: "memory");
}
__device__ __forceinline__ void p0_convert(const Ctx& C, const float* __restrict__ src, bf16_t* __restrict__ dst, long n8) {
    const long gt = (long)C.vcu * NTHREADS + C.tid, NGT = (long)C.G * NTHREADS;
    long i = gt;
    for (; i + 3 * NGT < n8; i += 4 * NGT) {
        f32x4 a[4], b[4];
#pragma unroll
        for (int u = 0; u < 4; ++u) { a[u] = __builtin_nontemporal_load((const f32x4*)(src + (i + u * NGT) * 8)); b[u] = __builtin_nontemporal_load((const f32x4*)(src + (i + u * NGT) * 8 + 4)); }
#pragma unroll
        for (int u = 0; u < 4; ++u) { u32x4 o; o.x = pk2(a[u][0], a[u][1]); o.y = pk2(a[u][2], a[u][3]); o.z = pk2(b[u][0], b[u][1]); o.w = pk2(b[u][2], b[u][3]); *(u32x4*)(dst + (i + u * NGT) * 8) = o; }
    }
    for (; i < n8; i += NGT) {
        const f32x4 a = *(const f32x4*)(src + i * 8), b = *(const f32x4*)(src + i * 8 + 4);
        u32x4 o; o.x = pk2(a[0], a[1]); o.y = pk2(a[2], a[3]); o.z = pk2(b[0], b[1]); o.w = pk2(b[2], b[3]);
        *(u32x4*)(dst + i * 8) = o;
    }
}

__device__ __forceinline__ void p0_convert_rowscale(const Ctx& C, const float* __restrict__ src, bf16_t* __restrict__ dst, const float* __restrict__ g, long n8) {
    const long gt = (long)C.vcu * NTHREADS + C.tid, NGT = (long)C.G * NTHREADS;
    for (long i = gt; i < n8; i += NGT) { const float sc = g[i >> 8];
        const f32x4 a = *(const f32x4*)(src + i * 8) * sc, b = *(const f32x4*)(src + i * 8 + 4) * sc;
        u32x4 o; o.x = pk2(a[0], a[1]); o.y = pk2(a[2], a[3]); o.z = pk2(b[0], b[1]); o.w = pk2(b[2], b[3]);
        *(u32x4*)(dst + i * 8) = o; }
}
__device__ __forceinline__ void pass_knormrope(const Ctx& C, bf16_t* H, const float* __restrict__ kn) {
    const int l = C.lane, p = l & 31, isc = l >> 5;
    const int d1 = isc * 64 + p, d2 = d1 + 32;
    const float invf = exp2f(-(float)p * (13.287712379549449f / 32.0f));
    const float gk1 = kn[d1], gk2 = kn[d2];
    bf16_t r1[2], r2[2];
#define KNR_LOAD(row_) do { const bf16_t* hn_ = H + (size_t)(row_) * HP + C_AK; r1[0] = hn_[d1]; r2[0] = hn_[d2]; r1[1] = hn_[128 + d1]; r2[1] = hn_[128 + d2]; } while (0)
    int row = C.gw; if (row < NT) KNR_LOAD(row);
    for (; row < NT; row += C.NGW) {
        const int t = row & (SEQ - 1); const float pos = (float)(isc ? (t & 63) : (t >> 6));
        const float ang = pos * invf; const float rev = ang * 0.15915494309189535f; const float fr = rev - floorf(rev);
        const float sn = __builtin_amdgcn_sinf(fr), cs = __builtin_amdgcn_cosf(fr);
        bf16_t* hr = H + (size_t)row * HP + C_AK;
        float z1[2], z2[2], ss[2];
#pragma unroll
        for (int hd = 0; hd < 2; ++hd) { z1[hd] = bf2f(r1[hd]); z2[hd] = bf2f(r2[hd]); ss[hd] = z1[hd] * z1[hd] + z2[hd] * z2[hd]; }
        if (row + C.NGW < NT) KNR_LOAD(row + C.NGW);
#pragma unroll
        for (int o = 1; o < 64; o <<= 1) { ss[0] += __shfl_xor(ss[0], o); ss[1] += __shfl_xor(ss[1], o); }
#pragma unroll
        for (int hd = 0; hd < 2; ++hd) { const float rstd = 1.0f / sqrtf(ss[hd] * (1.0f / 128.0f) + RMS_EPS);
            const float a = z1[hd] * rstd * gk1, b = z2[hd] * rstd * gk2;
            hr[hd * 128 + d1] = (bf16_t)f2bf(a * cs - b * sn); hr[hd * 128 + d2] = (bf16_t)f2bf(a * sn + b * cs); }
    }
#undef KNR_LOAD
}

__device__ __forceinline__ void pass_mlpost(const Ctx& C, const bf16_t* __restrict__ HF, const bf16_t* __restrict__ HBk, const bf16_t* __restrict__ H, const float* __restrict__ mlnorm, bf16_t* __restrict__ CC) {
    u32x2 ra[4], rb[4], rm[4];
#define MLP_LOAD(row_) do { _Pragma("unroll") for (int hh = 0; hh < 4; ++hh) { const int col = hh * 256 + C.lane * 4; \
        ra[hh] = __builtin_nontemporal_load((const u32x2*)(HF + (size_t)(row_) * 1024 + col)); rb[hh] = __builtin_nontemporal_load((const u32x2*)(HBk + (size_t)(row_) * 1024 + col)); rm[hh] = __builtin_nontemporal_load((const u32x2*)(H + (size_t)(row_) * HP + C_MO + col)); } } while (0)
    int row = C.gw; if (row < NT) MLP_LOAD(row);
    for (; row < NT; row += C.NGW) {
        f32x4 v[4]; u32x2 mo[4]; float ss[4];
#pragma unroll
        for (int hh = 0; hh < 4; ++hh) { const u32x2 a = ra[hh], b = rb[hh];
            v[hh] = (f32x4){bflo(a.x) + bflo(b.x), bfhi(a.x) + bfhi(b.x), bflo(a.y) + bflo(b.y), bfhi(a.y) + bfhi(b.y)}; mo[hh] = rm[hh];
            ss[hh] = v[hh][0] * v[hh][0] + v[hh][1] * v[hh][1] + v[hh][2] * v[hh][2] + v[hh][3] * v[hh][3]; }
        if (row + C.NGW < NT) MLP_LOAD(row + C.NGW);
#pragma unroll
        for (int o = 1; o < 64; o <<= 1) {
#pragma unroll
            for (int hh = 0; hh < 4; ++hh) ss[hh] += __shfl_xor(ss[hh], o); }
#pragma unroll
        for (int hh = 0; hh < 4; ++hh) { const int col = hh * 256 + C.lane * 4;
            const float rstd = 1.0f / sqrtf(ss[hh] * (1.0f / 256.0f) + RMS_EPS);
            const f32x4 g = *(const f32x4*)(mlnorm + col);
            const float m0 = bflo(mo[hh].x), m1 = bfhi(mo[hh].x), m2 = bflo(mo[hh].y), m3 = bfhi(mo[hh].y);
            const float o0 = v[hh][0] * rstd * g[0] / (1.0f + __expf(-m0)), o1 = v[hh][1] * rstd * g[1] / (1.0f + __expf(-m1));
            const float o2 = v[hh][2] * rstd * g[2] / (1.0f + __expf(-m2)), o3 = v[hh][3] * rstd * g[3] / (1.0f + __expf(-m3));
            u32x2 o; o.x = pk2(o0, o1); o.y = pk2(o2, o3);
            *(u32x2*)(CC + (size_t)row * DM + 1024 + col) = o; }
    }
#undef MLP_LOAD
}

__device__ __forceinline__ void pass_softmax(const Ctx& C, const float* __restrict__ SC, bf16_t* __restrict__ P) {
    for (int row = C.gw; row < NT; row += C.NGW) {
        const f32x4* sr = (const f32x4*)(SC + (size_t)row * 1024) + C.lane;
        u32x2* pr = (u32x2*)(P + (size_t)row * 1024) + C.lane;
        f32x4 v[4]; float mx[4], sm[4];
#pragma unroll
        for (int h = 0; h < 4; ++h) { v[h] = sr[64 * h]; mx[h] = fmaxf(fmaxf(v[h][0], v[h][1]), fmaxf(v[h][2], v[h][3])); }
#pragma unroll
        for (int o = 1; o < 64; o <<= 1) {
#pragma unroll
            for (int h = 0; h < 4; ++h) mx[h] = fmaxf(mx[h], __shfl_xor(mx[h], o)); }
#pragma unroll
        for (int h = 0; h < 4; ++h) { v[h][0] = __expf(v[h][0] - mx[h]); v[h][1] = __expf(v[h][1] - mx[h]); v[h][2] = __expf(v[h][2] - mx[h]); v[h][3] = __expf(v[h][3] - mx[h]); sm[h] = (v[h][0] + v[h][1]) + (v[h][2] + v[h][3]); }
#pragma unroll
        for (int o = 1; o < 64; o <<= 1) {
#pragma unroll
            for (int h = 0; h < 4; ++h) sm[h] += __shfl_xor(sm[h], o); }
#pragma unroll
        for (int h = 0; h < 4; ++h) { const float inv = 1.0f / sm[h]; u32x2 o; o.x = pk2(v[h][0] * inv, v[h][1] * inv); o.y = pk2(v[h][2] * inv, v[h][3] * inv); pr[64 * h] = o; }
    }
}

namespace attn {
constexpr int D = 128, NW = 8, QBLK = 32, KVBLK = 64;
constexpr float SCALE = 0.088388347648318440f;
constexpr float THR = 8.f;
constexpr int LDQ = HP, LDK = HP, LDO = DM;
constexpr size_t SHM_V = KVBLK * D * 2, SHM_K = KVBLK * D * 2, SHM_ATTN = 2 * SHM_V + 2 * SHM_K + NW * 64 * 4;
#define KSWZ(row, colB) ((row) * 256 + ((colB) ^ (((row) & 7) << 4)))
__device__ __forceinline__ unsigned cvtpk(float lo, float hi) { unsigned r; asm volatile("v_cvt_pk_bf16_f32 %0, %1, %2" : "=v"(r) : "v"(lo), "v"(hi)); return r; }
__device__ __forceinline__ void partialSM(f32x16& p0, f32x16& p1, float& m_reg, float& mn, float& alpha) {
  constexpr float C = SCALE * 1.4426950408889634f;
  float pmax = p0[0]; for (int r = 1; r < 16; ++r) pmax = fmaxf(pmax, p0[r]); for (int r = 0; r < 16; ++r) pmax = fmaxf(pmax, p1[r]);
  { auto rr = __builtin_amdgcn_permlane32_swap(__float_as_uint(pmax), __float_as_uint(pmax), false, false);
    pmax = fmaxf(__uint_as_float(rr[0]), __uint_as_float(rr[1])); }
  if (__builtin_expect(__all(pmax - m_reg <= THR / SCALE), 1)) { mn = m_reg; alpha = 1.f; }
  else { mn = fmaxf(m_reg, pmax); alpha = __builtin_amdgcn_exp2f((m_reg - mn) * C); m_reg = mn; }
  float mnC = -mn * C;
  for (int r = 0; r < 16; ++r) p0[r] = fmaf(p0[r], C, mnC); for (int r = 0; r < 16; ++r) p1[r] = fmaf(p1[r], C, mnC);
  for (int r = 0; r < 16; ++r) p0[r] = __builtin_amdgcn_exp2f(p0[r]);
}
__device__ __forceinline__ void finishSM(f32x16& p0, f32x16& p1, float alpha, float& l_reg, bf16x8& pa0, bf16x8& pa1, bf16x8& pa2, bf16x8& pa3) {
  for (int r = 0; r < 16; ++r) p1[r] = __builtin_amdgcn_exp2f(p1[r]);
  float ps = 0; for (int r = 0; r < 16; ++r) ps += p0[r]; for (int r = 0; r < 16; ++r) ps += p1[r];
  { auto rr = __builtin_amdgcn_permlane32_swap(__float_as_uint(ps), __float_as_uint(ps), false, false);
    ps = __uint_as_float(rr[0]) + __uint_as_float(rr[1]); }
  l_reg = l_reg * alpha + ps;
#define PK4(P, BASE, OUT) do { unsigned a0 = cvtpk(P[BASE + 0], P[BASE + 1]), a1 = cvtpk(P[BASE + 2], P[BASE + 3]);   \
    unsigned b0 = cvtpk(P[BASE + 4], P[BASE + 5]), b1 = cvtpk(P[BASE + 6], P[BASE + 7]);                              \
    auto r0 = __builtin_amdgcn_permlane32_swap(a0, b0, false, false); auto r1 = __builtin_amdgcn_permlane32_swap(a1, b1, false, false); \
    u32x4 w = {r0[0], r1[0], r0[1], r1[1]}; OUT = *reinterpret_cast<bf16x8*>(&w); } while (0)
  PK4(p0, 0, pa0); PK4(p0, 8, pa1); PK4(p1, 0, pa2); PK4(p1, 8, pa3);
#undef PK4
}
__device__ __forceinline__ void qkt(f32x16& p0, f32x16& p1, const bf16_t* Ks, const bf16x8* qr, int r32, int hi) {
  p0 = f32x16{}; p1 = f32x16{};
  for (int d0 = 0; d0 < 8; ++d0) { int cb = (d0 * 16 + hi * 8) * 2;
    bf16x8 b0 = *reinterpret_cast<const bf16x8*>((const char*)Ks + KSWZ(r32, cb));
    bf16x8 b1 = *reinterpret_cast<const bf16x8*>((const char*)Ks + KSWZ(32 + r32, cb));
    p0 = __builtin_amdgcn_mfma_f32_32x32x16_bf16(b0, qr[d0], p0, 0, 0, 0);
    p1 = __builtin_amdgcn_mfma_f32_32x32x16_bf16(b1, qr[d0], p1, 0, 0, 0); }
}
__device__ __forceinline__ int v_st(int k, int c) { const int kk = (k & ~0xC) | ((k & 4) << 1) | ((k & 8) >> 1); return ((kk >> 3) * 4 + (c >> 5)) * 512 + ((kk & 7) * 32 + (c & 31)) * 2; }
__device__ __forceinline__ int v_rd_base(int lane) { return ((lane & 3) << 3) | (((lane >> 2) & 3) << 6) | (((lane >> 4) & 1) << 5) | (((lane >> 5) & 1) << 8); }
constexpr int v_rd_off(int d0, int ks, int half) { return d0 * 512 + ks * 4096 + half * 2048; }
template <int OFF> __device__ __forceinline__ s16x4 tr_read(int vb) {
  s16x4 r; asm volatile("ds_read_b64_tr_b16 %0, %1 offset:%2" : "=&v"(r) : "v"(vb), "i"(OFF) : "memory"); return r;
}
template <int D0> __device__ __forceinline__ void pv_one(f32x16& od, int vb, bf16x8 pa0, bf16x8 pa1, bf16x8 pa2, bf16x8 pa3) {
  const s16x4 l0 = tr_read<v_rd_off(D0, 0, 0)>(vb), h0 = tr_read<v_rd_off(D0, 0, 1)>(vb), l1 = tr_read<v_rd_off(D0, 1, 0)>(vb), h1 = tr_read<v_rd_off(D0, 1, 1)>(vb);
  const s16x4 l2 = tr_read<v_rd_off(D0, 2, 0)>(vb), h2 = tr_read<v_rd_off(D0, 2, 1)>(vb), l3 = tr_read<v_rd_off(D0, 3, 0)>(vb), h3 = tr_read<v_rd_off(D0, 3, 1)>(vb);
  asm volatile("s_waitcnt lgkmcnt(0)" ::: "memory"); SBAR();
#define PK(L, H) (bf16x8){L[0], L[1], L[2], L[3], H[0], H[1], H[2], H[3]}
  od = __builtin_amdgcn_mfma_f32_32x32x16_bf16(pa0, PK(l0, h0), od, 0, 0, 0);
  od = __builtin_amdgcn_mfma_f32_32x32x16_bf16(pa1, PK(l1, h1), od, 0, 0, 0);
  od = __builtin_amdgcn_mfma_f32_32x32x16_bf16(pa2, PK(l2, h2), od, 0, 0, 0);
  od = __builtin_amdgcn_mfma_f32_32x32x16_bf16(pa3, PK(l3, h3), od, 0, 0, 0);
#undef PK
}
__device__ __forceinline__ void pv_d0(f32x16* o, int vb, bf16x8 pa0, bf16x8 pa1, bf16x8 pa2, bf16x8 pa3) {
  pv_one<0>(o[0], vb, pa0, pa1, pa2, pa3); pv_one<1>(o[1], vb, pa0, pa1, pa2, pa3); pv_one<2>(o[2], vb, pa0, pa1, pa2, pa3); pv_one<3>(o[3], vb, pa0, pa1, pa2, pa3);
}
__device__ __forceinline__ void q_norm_rope_frag(const bf16_t* __restrict__ Qw, const float* __restrict__ qgain, int hi, int tq, bf16x8 (&qr)[8]) {
    int hio = hi; asm volatile("" : "+v"(hio));
    float ss = 0.f;
#pragma unroll
    for (int d0 = 0; d0 < 8; ++d0) { qr[d0] = *reinterpret_cast<const bf16x8*>(Qw + d0 * 16);
#pragma unroll
      for (int j = 0; j < 8; ++j) { const float v = bf2f((unsigned short)qr[d0][j]); ss += v * v; } }
    { auto rr = __builtin_amdgcn_permlane32_swap(__float_as_uint(ss), __float_as_uint(ss), false, false); ss = __uint_as_float(rr[0]) + __uint_as_float(rr[1]); }
    const float rstd = 1.0f / sqrtf(ss * (1.0f / 128.0f) + RMS_EPS);
#pragma unroll
    for (int hf = 0; hf < 2; ++hf) {
      const float pos = (float)(hf ? (tq & 63) : (tq >> 6));
#pragma unroll
      for (int dq = 0; dq < 2; ++dq) { const int da = 4 * hf + dq, db = da + 2;
        const f32x4 ga0 = *(const f32x4*)(qgain + 16 * da + 8 * hio), ga1 = *(const f32x4*)(qgain + 16 * da + 8 * hio + 4), gb0 = *(const f32x4*)(qgain + 16 * db + 8 * hio), gb1 = *(const f32x4*)(qgain + 16 * db + 8 * hio + 4);
        float za[8], zb[8];
#pragma unroll
        for (int j = 0; j < 8; ++j) { const float ga = j < 4 ? ga0[j & 3] : ga1[j & 3], gb = j < 4 ? gb0[j & 3] : gb1[j & 3];
          const float z1 = bf2f((unsigned short)qr[da][j]) * rstd * ga, z2 = bf2f((unsigned short)qr[db][j]) * rstd * gb;
          const int p = 16 * dq + 8 * hio + j; const float invf = exp2f(-(float)p * (13.287712379549449f / 32.0f));
          const float rev = pos * invf * 0.15915494309189535f, fr = rev - floorf(rev); const float sn = __builtin_amdgcn_sinf(fr), cs = __builtin_amdgcn_cosf(fr);
          za[j] = z1 * cs - z2 * sn; zb[j] = z1 * sn + z2 * cs; }
        { u32x4 w = {cvt_pk_bf16(za[0], za[1]), cvt_pk_bf16(za[2], za[3]), cvt_pk_bf16(za[4], za[5]), cvt_pk_bf16(za[6], za[7])}; qr[da] = *reinterpret_cast<bf16x8*>(&w); }
        { u32x4 w = {cvt_pk_bf16(zb[0], zb[1]), cvt_pk_bf16(zb[2], zb[3]), cvt_pk_bf16(zb[4], zb[5]), cvt_pk_bf16(zb[6], zb[7])}; qr[db] = *reinterpret_cast<bf16x8*>(&w); }
        SBAR(); } }
}
__device__ __forceinline__ void attn_dense_body(const bf16_t* __restrict__ Qb, const bf16_t* __restrict__ Kh, const bf16_t* __restrict__ Vh, bf16_t* __restrict__ Ob, int seq, char* lds, int tid, int wid, const float* __restrict__ qgain, int t0) {
  const int lane = tid & 63, r32 = lane & 31, hi = lane >> 5;
  bf16_t* V_lds = (bf16_t*)lds; bf16_t* K_lds = (bf16_t*)(lds + 2 * SHM_V);
  float* ws = (float*)(lds + 2 * SHM_V + 2 * SHM_K) + wid * 64; float* li_l = ws; float* al_l = ws + 32;
  bf16x8 qr[8];
  const bf16_t* Qw = Qb + (long)(wid * QBLK + r32) * LDQ + hi * 8;
  q_norm_rope_frag(Qw, qgain, hi, t0 + wid * QBLK + r32, qr);
  float m_reg = -1e30f, l_reg = 0; f32x16 o[4] = {};
  const int sr = tid >> 4, sc = (tid & 15) * 8, vst0 = v_st(sr, sc), vst1 = v_st(32 + sr, sc);
  const int vb0 = (int)(uintptr_t)V_lds + v_rd_base(lane);
  struct { bf16x8 vs0, vs1, ks0, ks1; } sr_[2];
#define SLOAD(i, k0) do { sr_[i].vs0 = *reinterpret_cast<const bf16x8*>(&Vh[(long)((k0) + sr) * LDK + sc]); sr_[i].vs1 = *reinterpret_cast<const bf16x8*>(&Vh[(long)((k0) + 32 + sr) * LDK + sc]); \
    sr_[i].ks0 = *reinterpret_cast<const bf16x8*>(&Kh[(long)((k0) + sr) * LDK + sc]); sr_[i].ks1 = *reinterpret_cast<const bf16x8*>(&Kh[(long)((k0) + 32 + sr) * LDK + sc]); } while (0)
#define SWRITE(b, i) do { *(bf16x8*)((char*)V_lds + (b) * SHM_V + vst0) = sr_[i].vs0;          \
    *(bf16x8*)((char*)V_lds + (b) * SHM_V + vst1) = sr_[i].vs1; int kc = sc * 2;               \
    *(bf16x8*)((char*)K_lds + (b) * SHM_K + KSWZ(sr, kc)) = sr_[i].ks0;                       \
    *(bf16x8*)((char*)K_lds + (b) * SHM_K + KSWZ(32 + sr, kc)) = sr_[i].ks1; } while (0)
#define SWAIT() asm volatile("s_waitcnt vmcnt(4)" ::: "memory")
#define RESC(a) do { if (__any((a) < 1.f)) { if (hi == 0) al_l[r32] = (a); asm volatile("s_waitcnt lgkmcnt(0)" ::: "memory"); \
    for (int d = 0; d < 4; ++d) for (int r = 0; r < 16; ++r) o[d][r] *= al_l[crow(r, hi)]; } } while (0)
  f32x16 pA0, pA1, pB0, pB1; float mnA, mnB, alA, alB; bf16x8 pa0, pa1, pa2, pa3; const int NTL = seq / KVBLK;
  constexpr int SE = 0, SO = 1;
  SLOAD(SE, 0); asm volatile("s_waitcnt vmcnt(0)" ::: "memory"); SWRITE(0, SE); __syncthreads();
  qkt(pA0, pA1, K_lds, qr, r32, hi); partialSM(pA0, pA1, m_reg, mnA, alA);
  SLOAD(SO, KVBLK); if (2 < NTL) SLOAD(SE, 2 * KVBLK);
  SWAIT(); SWRITE(1, SO); __syncthreads();
  for (int j = 1; j + 1 < NTL; j += 2) {
    SBAR(); qkt(pB0, pB1, (bf16_t*)((char*)K_lds + SHM_K), qr, r32, hi);
    finishSM(pA0, pA1, alA, l_reg, pa0, pa1, pa2, pa3); SBAR();
    SLOAD(SO, (j + 2) * KVBLK); SBAR();
    pv_d0(o, vb0, pa0, pa1, pa2, pa3); partialSM(pB0, pB1, m_reg, mnB, alB);
    __syncthreads(); SWAIT(); SWRITE(0, SE);
    RESC(alB); __syncthreads();
    SBAR(); qkt(pA0, pA1, K_lds, qr, r32, hi);
    finishSM(pB0, pB1, alB, l_reg, pa0, pa1, pa2, pa3); SBAR();
    if (j + 3 < NTL) SLOAD(SE, (j + 3) * KVBLK); SBAR();
    pv_d0(o, vb0 + (int)SHM_V, pa0, pa1, pa2, pa3); partialSM(pA0, pA1, m_reg, mnA, alA);
    __syncthreads(); SWAIT(); SWRITE(1, SO);
    RESC(alA); __syncthreads();
  }
  SBAR(); qkt(pB0, pB1, (bf16_t*)((char*)K_lds + SHM_K), qr, r32, hi);
  finishSM(pA0, pA1, alA, l_reg, pa0, pa1, pa2, pa3); SBAR();
  pv_d0(o, vb0, pa0, pa1, pa2, pa3); partialSM(pB0, pB1, m_reg, mnB, alB);
  __syncthreads(); RESC(alB);
  finishSM(pB0, pB1, alB, l_reg, pa0, pa1, pa2, pa3); SBAR();
  pv_d0(o, vb0 + (int)SHM_V, pa0, pa1, pa2, pa3);
  if (hi == 0) li_l[r32] = l_reg; asm volatile("s_waitcnt lgkmcnt(0)" ::: "memory");
  float rli[16];
#pragma unroll
  for (int r = 0; r < 16; ++r) rli[r] = __builtin_amdgcn_rcpf(li_l[crow(r, hi)]);
  bf16_t* Ow = Ob + (long)(wid * QBLK) * LDO;
#pragma unroll
  for (int r = 0; r < 16; ++r) { int orow = crow(r, hi);
    for (int d0 = 0; d0 < 4; ++d0) Ow[(long)orow * LDO + d0 * 32 + r32] = (bf16_t)f2bf(o[d0][r] * rli[r]); }
#undef SLOAD
#undef SWRITE
#undef SWAIT
#undef RESC
}
#undef KSWZ
}

namespace mlstm {
constexpr int QP = 136, TP = 72, CP = 136, VP = 40;
constexpr int QSB = 64 * QP * 2, VSB = 64 * VP * 2, PSB = 64 * TP * 2, CTB = 32 * CP * 2;
constexpr int O_QS = 0, O_KS = O_QS + 2 * QSB, O_VS = O_KS + 2 * QSB, O_WV = O_VS + 3 * VSB, O_PS = O_WV + 2 * VSB, O_CT = O_PS + 2 * PSB;
constexpr int O_TAB = O_CT + 2 * CTB;
constexpr int O_GB = O_TAB + 4 * 384 * 4, O_NV = O_GB + 4 * 128 * 4, O_DEN = O_NV + 2 * 512, O_END = O_DEN + 2 * 256 * 4;
constexpr int O_HB = LDSCTL_OFF + 1024, HBB = 64 * VP * 2;
static_assert(O_HB + 2 * HBB <= LDS_BYTES && O_END <= LDSCTL_OFF && (O_VS % 16) == 0 && (O_WV % 16) == 0 && (O_PS % 16) == 0 && (O_CT % 16) == 0 && (O_TAB % 16) == 0 && (O_NV % 16) == 0, "mlstm LDS map");
constexpr float KSCALE = 0.08838834764831845f;
constexpr float LOG2E = 1.4426950408889634f, LOG2_KSCALE = -3.5f;

#define MFMA32(a, b, c) __builtin_amdgcn_mfma_f32_32x32x16_bf16(a, b, c, 0, 0, 0)
__device__ __forceinline__ s16x4 trrd(int addr) { s16x4 r; asm volatile("ds_read_b64_tr_b16 %0, %1" : "=v"(r) : "v"(addr) : "memory"); return r; }
#define TR_WAIT() asm volatile("s_waitcnt lgkmcnt(0)" ::: "memory")
#define PK8(L, H) (bf16x8){L[0], L[1], L[2], L[3], H[0], H[1], H[2], H[3]}
__device__ __forceinline__ float psum_halves(float v) { auto rr = __builtin_amdgcn_permlane32_swap(__float_as_uint(v), __float_as_uint(v), false, false); return __uint_as_float(rr[0]) + __uint_as_float(rr[1]); }

__device__ __forceinline__ void item(const Ctx& C, int it, const bf16_t* __restrict__ H, const float* __restrict__ gates, const float* __restrict__ b_ig, const float* __restrict__ b_fg, bf16_t* HF, bf16_t* HBk) {
    LAS unsigned char* lds = C.lds;
    const int tid = C.tid, lane = C.lane, wid = C.wave, r32 = lane & 31, hi = lane >> 5;
    const int seq = it >> 3, sl = it & 7, bb = seq >> 3, hh = (seq >> 1) & 3, dir = seq & 1;
    const size_t rowbase = (size_t)bb * SEQ;
    const bf16_t* qcol = H + C_MQ + hh * 128; const bf16_t* kcol = H + C_MK + hh * 128; const bf16_t* vcol = H + C_MV + hh * 256 + sl * 32;
    bf16_t* Hout = (dir ? HBk : HF) + hh * 256 + sl * 32;
    LAS float* tab = (LAS float*)(lds + O_TAB); LAS float* denp = (LAS float*)(lds + O_DEN);
#define TMAP(c, l) (dir ? (SEQ - 1 - (64 * (c) + (l))) : (64 * (c) + (l)))
    bf16x8 qreg[2], kreg[2], vreg = {};
    const int srow0 = tid & 31, sch = tid >> 5, vrow = tid & 63, vch = tid >> 6;
#define GLD16(dst, ptr) asm volatile("global_load_dwordx4 %0, %1, off" : "=v"(dst) : "v"(ptr) : "memory")
#define GLD4(dst, ptr) asm volatile("global_load_dword %0, %1, off" : "=v"(dst) : "v"(ptr) : "memory")
#define STAGE_LOAD(c) do { _Pragma("unroll") for (int i_ = 0; i_ < 2; ++i_) { const size_t gr_ = (rowbase + TMAP(c, srow0 + 32 * i_)) * HP + sch * 8; \
        GLD16(qreg[i_], qcol + gr_); GLD16(kreg[i_], kcol + gr_); } \
        if (tid < 256) GLD16(vreg, vcol + (rowbase + TMAP(c, vrow)) * HP + vch * 8); } while (0)
#define STAGE_WAIT() asm volatile("s_waitcnt vmcnt(0)" : "+v"(qreg[0]), "+v"(qreg[1]), "+v"(kreg[0]), "+v"(kreg[1]), "+v"(vreg), "+v"(g_i), "+v"(g_f) :: "memory")
#define STAGE_WRITE(c) do { const LAS float* tw_ = tab + ((c) & 3) * 384 + 256; \
        _Pragma("unroll") for (int i_ = 0; i_ < 2; ++i_) { const int l_ = srow0 + 32 * i_; \
            *(LAS bf16x8*)(lds + O_QS + ((c) & 1) * QSB + (l_ * QP + sch * 8) * 2) = qreg[i_]; *(LAS bf16x8*)(lds + O_KS + ((c) & 1) * QSB + (l_ * QP + sch * 8) * 2) = kreg[i_]; } \
        if (tid < 256) { const float w_ = tw_[vrow]; u32x4 wv_; \
            wv_.x = cvt_pk_bf16(bf2f((unsigned short)vreg[0]) * w_, bf2f((unsigned short)vreg[1]) * w_); wv_.y = cvt_pk_bf16(bf2f((unsigned short)vreg[2]) * w_, bf2f((unsigned short)vreg[3]) * w_); \
            wv_.z = cvt_pk_bf16(bf2f((unsigned short)vreg[4]) * w_, bf2f((unsigned short)vreg[5]) * w_); wv_.w = cvt_pk_bf16(bf2f((unsigned short)vreg[6]) * w_, bf2f((unsigned short)vreg[7]) * w_); \
            *(LAS bf16x8*)(lds + O_VS + ((c) % 3) * VSB + (vrow * VP + vch * 8) * 2) = vreg; *(LAS u32x4*)(lds + O_WV + ((c) & 1) * VSB + (vrow * VP + vch * 8) * 2) = wv_; } } while (0)
    float m_run = 0.f, g_i = 0.f, g_f = 0.f;
    const float big = b_ig[dir * 4 + hh], bfg = b_fg[dir * 4 + hh];
#define TLOAD(c) do { const size_t gr_ = (rowbase + TMAP(c, lane)) * 16; GLD4(g_i, gates + gr_ + dir * 4 + hh); GLD4(g_f, gates + gr_ + 8 + dir * 4 + hh); } while (0)
#define DPPMOV(idn, v, ctrl, rm) __builtin_bit_cast(float, __builtin_amdgcn_update_dpp(__builtin_bit_cast(int, (float)(idn)), __builtin_bit_cast(int, v), ctrl, rm, 0xf, false))
#define TCOMP(c) do { const float li_ = gbuf[((c) & 3) * 128 + lane] + big; const float gf_ = gbuf[((c) & 3) * 128 + 64 + lane] + bfg; \
        const float lf_ = fminf(gf_, 0.f) - __logf(1.0f + __expf(-fabsf(gf_))); \
        float b_ = lf_; b_ += DPPMOV(0.f, b_, 0x111, 0xf); b_ += DPPMOV(0.f, b_, 0x112, 0xf); b_ += DPPMOV(0.f, b_, 0x114, 0xf); b_ += DPPMOV(0.f, b_, 0x118, 0xf); \
        b_ += DPPMOV(0.f, b_, 0x142, 0xa); b_ += DPPMOV(0.f, b_, 0x143, 0xc); \
        const float blast_ = __builtin_bit_cast(float, __builtin_amdgcn_readlane(__builtin_bit_cast(int, b_), 63)); const float a_ = li_ - b_; \
        const float ninf_ = -__builtin_inff(); float pm_ = a_; \
        pm_ = fmaxf(pm_, DPPMOV(ninf_, pm_, 0x111, 0xf)); pm_ = fmaxf(pm_, DPPMOV(ninf_, pm_, 0x112, 0xf)); pm_ = fmaxf(pm_, DPPMOV(ninf_, pm_, 0x114, 0xf)); pm_ = fmaxf(pm_, DPPMOV(ninf_, pm_, 0x118, 0xf)); \
        pm_ = fmaxf(pm_, DPPMOV(ninf_, pm_, 0x142, 0xa)); pm_ = fmaxf(pm_, DPPMOV(ninf_, pm_, 0x143, 0xc)); \
        const float mm_ = fmaxf(m_run, pm_); const float amax_ = __builtin_bit_cast(float, __builtin_amdgcn_readlane(__builtin_bit_cast(int, pm_), 63)); \
        const float mnew_ = fmaxf(blast_ + m_run, blast_ + amax_); \
        LAS float* tb_ = tab + ((c) & 3) * 384; \
        tb_[lane] = -mm_ * LOG2E + LOG2_KSCALE; tb_[64 + lane] = a_ * LOG2E; tb_[128 + lane] = __expf(m_run - mm_); tb_[192 + lane] = __expf(-(b_ + mm_)); \
        tb_[256 + lane] = __expf(blast_ + a_ - mnew_) * KSCALE; if (lane == 0) tb_[320] = __expf(blast_ + m_run - mnew_); \
        m_run = mnew_; } while (0)

#define BAR() do { LDS_WAIT(); __builtin_amdgcn_s_barrier(); asm volatile("" ::: "memory"); } while (0)
    LAS float* gbuf = (LAS float*)(lds + O_GB);
#define GSAVE(c) do { gbuf[((c) & 3) * 128 + lane] = g_i; gbuf[((c) & 3) * 128 + 64 + lane] = g_f; } while (0)
    for (int i = tid; i < 2 * CTB / 4; i += NTHREADS) ((LAS unsigned*)(lds + O_CT))[i] = 0u;
    if (tid < 256) ((LAS unsigned*)(lds + O_NV))[tid] = 0u;
    denp[tid] = 0.f;
    if (wid == 5) { TLOAD(0); STAGE_WAIT(); GSAVE(0); TCOMP(0); TLOAD(1); STAGE_WAIT(); GSAVE(1); TCOMP(1); TLOAD(2); STAGE_WAIT(); GSAVE(2); TLOAD(3); }
    STAGE_LOAD(0);
    STAGE_WAIT();
    BAR();
    STAGE_WRITE(0);
    STAGE_LOAD(1);
    f32x16 cacc = {}, nacc = {};
    f32x16 acc2 = {}; float qnl = 0.f;
    BAR();
#define FINALIZE(cm) do { const LAS float* tbm = tab + ((cm) & 3) * 384; const int li = wid - 4; f32x16 acc3 = {}; const int nks = li ? 4 : 2; \
            const int l = 32 * li + r32; const float wi = tbm[128 + l]; const LAS float* dp = denp + ((cm) & 1) * 256; \
            const float den = (dp[l] + dp[64 + l]) + (dp[128 + l] + dp[192 + l]) + wi * qnl; const float enl = tbm[192 + l]; \
            bf16x8 pb[4]; \
            _Pragma("unroll") for (int t = 0; t < 4; ++t) if (t < nks) pb[t] = *(const LAS bf16x8*)(lds + O_PS + ((cm) & 1) * PSB + ((32 * li + r32) * TP + 16 * t + 8 * hi) * 2); \
            const int aV = (int)(uintptr_t)(lds + O_VS + ((cm) % 3) * VSB) + ((8 * hi + trq) * VP + 16 * trg + 4 * trp) * 2; \
            s16x4 vl[4], vh[4]; \
            _Pragma("unroll") for (int t = 0; t < 4; ++t) if (t < nks) { vl[t] = trrd(aV + 16 * t * VP * 2); vh[t] = trrd(aV + (16 * t + 4) * VP * 2); } \
            TR_WAIT(); \
            _Pragma("unroll") for (int t = 0; t < 4; ++t) if (t < nks) acc3 = MFMA32(PK8(vl[t], vh[t]), pb[t], acc3); \
            const float rinv = __builtin_amdgcn_rcpf(fmaxf(fabsf(den), enl)); \
            _Pragma("unroll") for (int g = 0; g < 4; ++g) { u32x2 hw; \
                hw.x = cvt_pk_bf16((acc3[4 * g] + wi * acc2[4 * g]) * rinv, (acc3[4 * g + 1] + wi * acc2[4 * g + 1]) * rinv); \
                hw.y = cvt_pk_bf16((acc3[4 * g + 2] + wi * acc2[4 * g + 2]) * rinv, (acc3[4 * g + 3] + wi * acc2[4 * g + 3]) * rinv); \
                *(LAS u32x2*)(lds + O_HB + ((cm) & 1) * HBB + (l * VP + 8 * g + 4 * hi) * 2) = hw; } } while (0)
#define HSTORE(cm) do { _Pragma("unroll") for (int u_ = 0; u_ < 2; ++u_) { const int p_ = (wid - 6) * 64 + lane + 128 * u_, row_ = p_ >> 2, q_ = p_ & 3; \
        const u32x4 hv_ = *(const LAS u32x4*)(lds + O_HB + ((cm) & 1) * HBB + row_ * VP * 2 + q_ * 16); \
        *(u32x4*)(Hout + (rowbase + TMAP(cm, row_)) * 1024 + q_ * 8) = hv_; } } while (0)
#define RESTAGE(c) do { STAGE_WAIT(); if ((c) + 1 < 64) { STAGE_WRITE((c) + 1); if ((c) + 2 < 64) STAGE_LOAD((c) + 2); } \
        if (wid == 5) { if ((c) + 3 < 64) GSAVE((c) + 3); if ((c) + 4 < 64) TLOAD((c) + 4); } } while (0)
    for (int c = 0; c < 64; ++c) {
        const LAS float* tb = tab + (c & 3) * 384;
        if (wid > 5 && c > 1) HSTORE(c - 2);
        if (wid < 4 || wid > 5) {
            int lo_ = lane; asm volatile("" : "+v"(lo_));
            const int r32 = lo_ & 31, hi = lo_ >> 5, trq = (lo_ & 15) >> 2, trp = lo_ & 3, trg = (lo_ >> 4) & 1;
            const int job = (wid < 4) ? wid : wid - 2, tile = (job >= 3) ? job - 3 : job, si = tile >> 1, li = (tile + 1) >> 1;
            f32x16 acc = {};
#pragma unroll
            for (int t = 0; t < 8; ++t) {
                const bf16x8 a = *(const LAS bf16x8*)(lds + O_KS + (c & 1) * QSB + ((32 * si + r32) * QP + 16 * t + 8 * hi) * 2);
                const bf16x8 b = *(const LAS bf16x8*)(lds + O_QS + (c & 1) * QSB + ((32 * li + r32) * QP + 16 * t + 8 * hi) * 2);
                acc = MFMA32(a, b, acc);
            }
            const int l = 32 * li + r32; const float g1l = tb[l];
#define S_HALF(P_) do { float ps = 0.f; \
            _Pragma("unroll") for (int g = 2 * (P_); g < 2 * (P_) + 2; ++g) { const f32x4 g2 = *(const LAS f32x4*)(tb + 64 + 32 * si + 8 * g + 4 * hi); float pv[4]; \
                _Pragma("unroll") for (int e = 0; e < 4; ++e) { const int s_ = 32 * si + 8 * g + 4 * hi + e; const float v = (s_ <= l) ? acc[4 * g + e] * __builtin_amdgcn_exp2f(g1l + g2[e]) : 0.f; pv[e] = v; ps += v; } \
                u32x2 w; w.x = cvt_pk_bf16(pv[0], pv[1]); w.y = cvt_pk_bf16(pv[2], pv[3]); \
                *(LAS u32x2*)(lds + O_PS + (c & 1) * PSB + (l * TP + 32 * si + 8 * g + 4 * hi) * 2) = w; } \
            ps = psum_halves(ps); if (hi == 0) denp[(c & 1) * 256 + (2 * si + (P_)) * 64 + l] = ps; } while (0)
            if (job < 3) S_HALF(0); else S_HALF(1);
#undef S_HALF
            if (wid < 4) {
                const float decay = tb[320];
                const int aK = (int)(uintptr_t)(lds + O_KS + (c & 1) * QSB) + ((8 * hi + trq) * QP + 32 * wid + 16 * trg + 4 * trp) * 2;
                const int aW = (int)(uintptr_t)(lds + O_WV + (c & 1) * VSB) + ((8 * hi + trq) * VP + 16 * trg + 4 * trp) * 2;
                s16x4 kl[4], kh[4], wl[4], wh[4];
#pragma unroll
                for (int t = 0; t < 4; ++t) { kl[t] = trrd(aK + 16 * t * QP * 2); kh[t] = trrd(aK + (16 * t + 4) * QP * 2); wl[t] = trrd(aW + 16 * t * VP * 2); wh[t] = trrd(aW + (16 * t + 4) * VP * 2); }
#pragma unroll
                for (int r = 0; r < 16; ++r) { cacc[r] *= decay; nacc[r] *= decay; }
                TR_WAIT();
#pragma unroll
                for (int t = 0; t < 4; ++t) {
                    const f32x4 w0 = *(const LAS f32x4*)(tb + 256 + 16 * t + 8 * hi), w1 = *(const LAS f32x4*)(tb + 256 + 16 * t + 8 * hi + 4);
                    u32x4 wb; wb.x = cvt_pk_bf16(w0[0], w0[1]); wb.y = cvt_pk_bf16(w0[2], w0[3]); wb.z = cvt_pk_bf16(w1[0], w1[1]); wb.w = cvt_pk_bf16(w1[2], w1[3]);
                    if (r32 != 0) wb = (u32x4){0u, 0u, 0u, 0u};
                    const bf16x8 a = PK8(kl[t], kh[t]);
                    cacc = MFMA32(a, PK8(wl[t], wh[t]), cacc);
                    nacc = MFMA32(a, __builtin_bit_cast(bf16x8, wb), nacc);
                }
#pragma unroll
                for (int g = 0; g < 4; ++g) { u32x2 w; w.x = cvt_pk_bf16(cacc[4 * g], cacc[4 * g + 1]); w.y = cvt_pk_bf16(cacc[4 * g + 2], cacc[4 * g + 3]);
                    *(LAS u32x2*)(lds + O_CT + (c & 1) * CTB + (r32 * CP + 32 * wid + 8 * g + 4 * hi) * 2) = w; }
                if (r32 == 0) {
#pragma unroll
                    for (int g = 0; g < 4; ++g) { u32x2 h2, l2; h2.x = cvt_pk_bf16(nacc[4 * g], nacc[4 * g + 1]); h2.y = cvt_pk_bf16(nacc[4 * g + 2], nacc[4 * g + 3]);
                        l2.x = cvt_pk_bf16(nacc[4 * g] - bflo(h2.x), nacc[4 * g + 1] - bfhi(h2.x)); l2.y = cvt_pk_bf16(nacc[4 * g + 2] - bflo(h2.y), nacc[4 * g + 3] - bfhi(h2.y));
                        *(LAS u32x2*)(lds + O_NV + (c & 1) * 512 + (32 * wid + 8 * g + 4 * hi) * 2) = h2; *(LAS u32x2*)(lds + O_NV + (c & 1) * 512 + 256 + (32 * wid + 8 * g + 4 * hi) * 2) = l2; } }
            }
        } else {
            int lo_ = lane; asm volatile("" : "+v"(lo_));
            const int r32 = lo_ & 31, hi = lo_ >> 5, trq = (lo_ & 15) >> 2, trp = lo_ & 3, trg = (lo_ >> 4) & 1;
            if (c > 0) FINALIZE(c - 1);
            const int li = wid - 4; f32x16 accq = {}; acc2 = (f32x16){};
#pragma unroll
            for (int t = 0; t < 8; ++t) {
                const bf16x8 a = *(const LAS bf16x8*)(lds + O_CT + ((c + 1) & 1) * CTB + (r32 * CP + 16 * t + 8 * hi) * 2);
                const bf16x8 b = *(const LAS bf16x8*)(lds + O_QS + (c & 1) * QSB + ((32 * li + r32) * QP + 16 * t + 8 * hi) * 2);
                acc2 = MFMA32(a, b, acc2);
                u32x4 na = *(const LAS u32x4*)(lds + O_NV + ((c + 1) & 1) * 512 + (r32 & 1) * 256 + (16 * t + 8 * hi) * 2);
                if (r32 & 0x1a) na = (u32x4){0u, 0u, 0u, 0u};
                accq = MFMA32(__builtin_bit_cast(bf16x8, na), b, accq);
            }
            qnl = accq[0] + accq[1];
            if (wid == 5 && c + 2 < 64) TCOMP(c + 2);
        }
        RESTAGE(c);
        BAR();
    }
    if (wid > 5) HSTORE(62);
    if (wid == 4 || wid == 5) { const int trq = (lane & 15) >> 2, trp = lane & 3, trg = (lane >> 4) & 1; FINALIZE(63); }
    BAR();
    if (wid > 5) HSTORE(63);
    BAR();
#undef FINALIZE
#undef HSTORE
#undef RESTAGE
    asm volatile("s_waitcnt vmcnt(0)" ::: "memory");
#undef BAR
#undef GSAVE
#undef GLD16
#undef GLD4
#undef STAGE_WAIT
#undef TMAP
#undef TR_WAIT
#undef PK8
#undef STAGE_LOAD
#undef STAGE_WRITE
#undef TLOAD
#undef TCOMP
#undef DPPMOV
}
#undef MFMA32
}
#define SORT16(A_, O_) do { { const unsigned h_ = A_[(O_) + 0] > A_[(O_) + 1] ? A_[(O_) + 0] : A_[(O_) + 1], l_ = A_[(O_) + 0] > A_[(O_) + 1] ? A_[(O_) + 1] : A_[(O_) + 0]; A_[(O_) + 0] = h_; A_[(O_) + 1] = l_; } { const unsigned h_ = A_[(O_) + 2] > A_[(O_) + 3] ? A_[(O_) + 2] : A_[(O_) + 3], l_ = A_[(O_) + 2] > A_[(O_) + 3] ? A_[(O_) + 3] : A_[(O_) + 2]; A_[(O_) + 2] = l_; A_[(O_) + 3] = h_; } { const unsigned h_ = A_[(O_) + 4] > A_[(O_) + 5] ? A_[(O_) + 4] : A_[(O_) + 5], l_ = A_[(O_) + 4] > A_[(O_) + 5] ? A_[(O_) + 5] : A_[(O_) + 4]; A_[(O_) + 4] = h_; A_[(O_) + 5] = l_; } { const unsigned h_ = A_[(O_) + 6] > A_[(O_) + 7] ? A_[(O_) + 6] : A_[(O_) + 7], l_ = A_[(O_) + 6] > A_[(O_) + 7] ? A_[(O_) + 7] : A_[(O_) + 6]; A_[(O_) + 6] = l_; A_[(O_) + 7] = h_; } { const unsigned h_ = A_[(O_) + 8] > A_[(O_) + 9] ? A_[(O_) + 8] : A_[(O_) + 9], l_ = A_[(O_) + 8] > A_[(O_) + 9] ? A_[(O_) + 9] : A_[(O_) + 8]; A_[(O_) + 8] = h_; A_[(O_) + 9] = l_; } { const unsigned h_ = A_[(O_) + 10] > A_[(O_) + 11] ? A_[(O_) + 10] : A_[(O_) + 11], l_ = A_[(O_) + 10] > A_[(O_) + 11] ? A_[(O_) + 11] : A_[(O_) + 10]; A_[(O_) + 10] = l_; A_[(O_) + 11] = h_; } { const unsigned h_ = A_[(O_) + 12] > A_[(O_) + 13] ? A_[(O_) + 12] : A_[(O_) + 13], l_ = A_[(O_) + 12] > A_[(O_) + 13] ? A_[(O_) + 13] : A_[(O_) + 12]; A_[(O_) + 12] = h_; A_[(O_) + 13] = l_; } { const unsigned h_ = A_[(O_) + 14] > A_[(O_) + 15] ? A_[(O_) + 14] : A_[(O_) + 15], l_ = A_[(O_) + 14] > A_[(O_) + 15] ? A_[(O_) + 15] : A_[(O_) + 14]; A_[(O_) + 14] = l_; A_[(O_) + 15] = h_; } { const unsigned h_ = A_[(O_) + 0] > A_[(O_) + 2] ? A_[(O_) + 0] : A_[(O_) + 2], l_ = A_[(O_) + 0] > A_[(O_) + 2] ? A_[(O_) + 2] : A_[(O_) + 0]; A_[(O_) + 0] = h_; A_[(O_) + 2] = l_; } { const unsigned h_ = A_[(O_) + 1] > A_[(O_) + 3] ? A_[(O_) + 1] : A_[(O_) + 3], l_ = A_[(O_) + 1] > A_[(O_) + 3] ? A_[(O_) + 3] : A_[(O_) + 1]; A_[(O_) + 1] = h_; A_[(O_) + 3] = l_; } { const unsigned h_ = A_[(O_) + 4] > A_[(O_) + 6] ? A_[(O_) + 4] : A_[(O_) + 6], l_ = A_[(O_) + 4] > A_[(O_) + 6] ? A_[(O_) + 6] : A_[(O_) + 4]; A_[(O_) + 4] = l_; A_[(O_) + 6] = h_; } { const unsigned h_ = A_[(O_) + 5] > A_[(O_) + 7] ? A_[(O_) + 5] : A_[(O_) + 7], l_ = A_[(O_) + 5] > A_[(O_) + 7] ? A_[(O_) + 7] : A_[(O_) + 5]; A_[(O_) + 5] = l_; A_[(O_) + 7] = h_; } { const unsigned h_ = A_[(O_) + 8] > A_[(O_) + 10] ? A_[(O_) + 8] : A_[(O_) + 10], l_ = A_[(O_) + 8] > A_[(O_) + 10] ? A_[(O_) + 10] : A_[(O_) + 8]; A_[(O_) + 8] = h_; A_[(O_) + 10] = l_; } { const unsigned h_ = A_[(O_) + 9] > A_[(O_) + 11] ? A_[(O_) + 9] : A_[(O_) + 11], l_ = A_[(O_) + 9] > A_[(O_) + 11] ? A_[(O_) + 11] : A_[(O_) + 9]; A_[(O_) + 9] = h_; A_[(O_) + 11] = l_; } { const unsigned h_ = A_[(O_) + 12] > A_[(O_) + 14] ? A_[(O_) + 12] : A_[(O_) + 14], l_ = A_[(O_) + 12] > A_[(O_) + 14] ? A_[(O_) + 14] : A_[(O_) + 12]; A_[(O_) + 12] = l_; A_[(O_) + 14] = h_; } { const unsigned h_ = A_[(O_) + 13] > A_[(O_) + 15] ? A_[(O_) + 13] : A_[(O_) + 15], l_ = A_[(O_) + 13] > A_[(O_) + 15] ? A_[(O_) + 15] : A_[(O_) + 13]; A_[(O_) + 13] = l_; A_[(O_) + 15] = h_; } { const unsigned h_ = A_[(O_) + 0] > A_[(O_) + 1] ? A_[(O_) + 0] : A_[(O_) + 1], l_ = A_[(O_) + 0] > A_[(O_) + 1] ? A_[(O_) + 1] : A_[(O_) + 0]; A_[(O_) + 0] = h_; A_[(O_) + 1] = l_; } { const unsigned h_ = A_[(O_) + 2] > A_[(O_) + 3] ? A_[(O_) + 2] : A_[(O_) + 3], l_ = A_[(O_) + 2] > A_[(O_) + 3] ? A_[(O_) + 3] : A_[(O_) + 2]; A_[(O_) + 2] = h_; A_[(O_) + 3] = l_; } { const unsigned h_ = A_[(O_) + 4] > A_[(O_) + 5] ? A_[(O_) + 4] : A_[(O_) + 5], l_ = A_[(O_) + 4] > A_[(O_) + 5] ? A_[(O_) + 5] : A_[(O_) + 4]; A_[(O_) + 4] = l_; A_[(O_) + 5] = h_; } { const unsigned h_ = A_[(O_) + 6] > A_[(O_) + 7] ? A_[(O_) + 6] : A_[(O_) + 7], l_ = A_[(O_) + 6] > A_[(O_) + 7] ? A_[(O_) + 7] : A_[(O_) + 6]; A_[(O_) + 6] = l_; A_[(O_) + 7] = h_; } { const unsigned h_ = A_[(O_) + 8] > A_[(O_) + 9] ? A_[(O_) + 8] : A_[(O_) + 9], l_ = A_[(O_) + 8] > A_[(O_) + 9] ? A_[(O_) + 9] : A_[(O_) + 8]; A_[(O_) + 8] = h_; A_[(O_) + 9] = l_; } { const unsigned h_ = A_[(O_) + 10] > A_[(O_) + 11] ? A_[(O_) + 10] : A_[(O_) + 11], l_ = A_[(O_) + 10] > A_[(O_) + 11] ? A_[(O_) + 11] : A_[(O_) + 10]; A_[(O_) + 10] = h_; A_[(O_) + 11] = l_; } { const unsigned h_ = A_[(O_) + 12] > A_[(O_) + 13] ? A_[(O_) + 12] : A_[(O_) + 13], l_ = A_[(O_) + 12] > A_[(O_) + 13] ? A_[(O_) + 13] : A_[(O_) + 12]; A_[(O_) + 12] = l_; A_[(O_) + 13] = h_; } { const unsigned h_ = A_[(O_) + 14] > A_[(O_) + 15] ? A_[(O_) + 14] : A_[(O_) + 15], l_ = A_[(O_) + 14] > A_[(O_) + 15] ? A_[(O_) + 15] : A_[(O_) + 14]; A_[(O_) + 14] = l_; A_[(O_) + 15] = h_; } { const unsigned h_ = A_[(O_) + 0] > A_[(O_) + 4] ? A_[(O_) + 0] : A_[(O_) + 4], l_ = A_[(O_) + 0] > A_[(O_) + 4] ? A_[(O_) + 4] : A_[(O_) + 0]; A_[(O_) + 0] = h_; A_[(O_) + 4] = l_; } { const unsigned h_ = A_[(O_) + 1] > A_[(O_) + 5] ? A_[(O_) + 1] : A_[(O_) + 5], l_ = A_[(O_) + 1] > A_[(O_) + 5] ? A_[(O_) + 5] : A_[(O_) + 1]; A_[(O_) + 1] = h_; A_[(O_) + 5] = l_; } { const unsigned h_ = A_[(O_) + 2] > A_[(O_) + 6] ? A_[(O_) + 2] : A_[(O_) + 6], l_ = A_[(O_) + 2] > A_[(O_) + 6] ? A_[(O_) + 6] : A_[(O_) + 2]; A_[(O_) + 2] = h_; A_[(O_) + 6] = l_; } { const unsigned h_ = A_[(O_) + 3] > A_[(O_) + 7] ? A_[(O_) + 3] : A_[(O_) + 7], l_ = A_[(O_) + 3] > A_[(O_) + 7] ? A_[(O_) + 7] : A_[(O_) + 3]; A_[(O_) + 3] = h_; A_[(O_) + 7] = l_; } { const unsigned h_ = A_[(O_) + 8] > A_[(O_) + 12] ? A_[(O_) + 8] : A_[(O_) + 12], l_ = A_[(O_) + 8] > A_[(O_) + 12] ? A_[(O_) + 12] : A_[(O_) + 8]; A_[(O_) + 8] = l_; A_[(O_) + 12] = h_; } { const unsigned h_ = A_[(O_) + 9] > A_[(O_) + 13] ? A_[(O_) + 9] : A_[(O_) + 13], l_ = A_[(O_) + 9] > A_[(O_) + 13] ? A_[(O_) + 13] : A_[(O_) + 9]; A_[(O_) + 9] = l_; A_[(O_) + 13] = h_; } { const unsigned h_ = A_[(O_) + 10] > A_[(O_) + 14] ? A_[(O_) + 10] : A_[(O_) + 14], l_ = A_[(O_) + 10] > A_[(O_) + 14] ? A_[(O_) + 14] : A_[(O_) + 10]; A_[(O_) + 10] = l_; A_[(O_) + 14] = h_; } { const unsigned h_ = A_[(O_) + 11] > A_[(O_) + 15] ? A_[(O_) + 11] : A_[(O_) + 15], l_ = A_[(O_) + 11] > A_[(O_) + 15] ? A_[(O_) + 15] : A_[(O_) + 11]; A_[(O_) + 11] = l_; A_[(O_) + 15] = h_; } { const unsigned h_ = A_[(O_) + 0] > A_[(O_) + 2] ? A_[(O_) + 0] : A_[(O_) + 2], l_ = A_[(O_) + 0] > A_[(O_) + 2] ? A_[(O_) + 2] : A_[(O_) + 0]; A_[(O_) + 0] = h_; A_[(O_) + 2] = l_; } { const unsigned h_ = A_[(O_) + 1] > A_[(O_) + 3] ? A_[(O_) + 1] : A_[(O_) + 3], l_ = A_[(O_) + 1] > A_[(O_) + 3] ? A_[(O_) + 3] : A_[(O_) + 1]; A_[(O_) + 1] = h_; A_[(O_) + 3] = l_; } { const unsigned h_ = A_[(O_) + 4] > A_[(O_) + 6] ? A_[(O_) + 4] : A_[(O_) + 6], l_ = A_[(O_) + 4] > A_[(O_) + 6] ? A_[(O_) + 6] : A_[(O_) + 4]; A_[(O_) + 4] = h_; A_[(O_) + 6] = l_; } { const unsigned h_ = A_[(O_) + 5] > A_[(O_) + 7] ? A_[(O_) + 5] : A_[(O_) + 7], l_ = A_[(O_) + 5] > A_[(O_) + 7] ? A_[(O_) + 7] : A_[(O_) + 5]; A_[(O_) + 5] = h_; A_[(O_) + 7] = l_; } { const unsigned h_ = A_[(O_) + 8] > A_[(O_) + 10] ? A_[(O_) + 8] : A_[(O_) + 10], l_ = A_[(O_) + 8] > A_[(O_) + 10] ? A_[(O_) + 10] : A_[(O_) + 8]; A_[(O_) + 8] = l_; A_[(O_) + 10] = h_; } { const unsigned h_ = A_[(O_) + 9] > A_[(O_) + 11] ? A_[(O_) + 9] : A_[(O_) + 11], l_ = A_[(O_) + 9] > A_[(O_) + 11] ? A_[(O_) + 11] : A_[(O_) + 9]; A_[(O_) + 9] = l_; A_[(O_) + 11] = h_; } { const unsigned h_ = A_[(O_) + 12] > A_[(O_) + 14] ? A_[(O_) + 12] : A_[(O_) + 14], l_ = A_[(O_) + 12] > A_[(O_) + 14] ? A_[(O_) + 14] : A_[(O_) + 12]; A_[(O_) + 12] = l_; A_[(O_) + 14] = h_; } { const unsigned h_ = A_[(O_) + 13] > A_[(O_) + 15] ? A_[(O_) + 13] : A_[(O_) + 15], l_ = A_[(O_) + 13] > A_[(O_) + 15] ? A_[(O_) + 15] : A_[(O_) + 13]; A_[(O_) + 13] = l_; A_[(O_) + 15] = h_; } { const unsigned h_ = A_[(O_) + 0] > A_[(O_) + 1] ? A_[(O_) + 0] : A_[(O_) + 1], l_ = A_[(O_) + 0] > A_[(O_) + 1] ? A_[(O_) + 1] : A_[(O_) + 0]; A_[(O_) + 0] = h_; A_[(O_) + 1] = l_; } { const unsigned h_ = A_[(O_) + 2] > A_[(O_) + 3] ? A_[(O_) + 2] : A_[(O_) + 3], l_ = A_[(O_) + 2] > A_[(O_) + 3] ? A_[(O_) + 3] : A_[(O_) + 2]; A_[(O_) + 2] = h_; A_[(O_) + 3] = l_; } { const unsigned h_ = A_[(O_) + 4] > A_[(O_) + 5] ? A_[(O_) + 4] : A_[(O_) + 5], l_ = A_[(O_) + 4] > A_[(O_) + 5] ? A_[(O_) + 5] : A_[(O_) + 4]; A_[(O_) + 4] = h_; A_[(O_) + 5] = l_; } { const unsigned h_ = A_[(O_) + 6] > A_[(O_) + 7] ? A_[(O_) + 6] : A_[(O_) + 7], l_ = A_[(O_) + 6] > A_[(O_) + 7] ? A_[(O_) + 7] : A_[(O_) + 6]; A_[(O_) + 6] = h_; A_[(O_) + 7] = l_; } { const unsigned h_ = A_[(O_) + 8] > A_[(O_) + 9] ? A_[(O_) + 8] : A_[(O_) + 9], l_ = A_[(O_) + 8] > A_[(O_) + 9] ? A_[(O_) + 9] : A_[(O_) + 8]; A_[(O_) + 8] = l_; A_[(O_) + 9] = h_; } { const unsigned h_ = A_[(O_) + 10] > A_[(O_) + 11] ? A_[(O_) + 10] : A_[(O_) + 11], l_ = A_[(O_) + 10] > A_[(O_) + 11] ? A_[(O_) + 11] : A_[(O_) + 10]; A_[(O_) + 10] = l_; A_[(O_) + 11] = h_; } { const unsigned h_ = A_[(O_) + 12] > A_[(O_) + 13] ? A_[(O_) + 12] : A_[(O_) + 13], l_ = A_[(O_) + 12] > A_[(O_) + 13] ? A_[(O_) + 13] : A_[(O_) + 12]; A_[(O_) + 12] = l_; A_[(O_) + 13] = h_; } { const unsigned h_ = A_[(O_) + 14] > A_[(O_) + 15] ? A_[(O_) + 14] : A_[(O_) + 15], l_ = A_[(O_) + 14] > A_[(O_) + 15] ? A_[(O_) + 15] : A_[(O_) + 14]; A_[(O_) + 14] = l_; A_[(O_) + 15] = h_; } { const unsigned h_ = A_[(O_) + 0] > A_[(O_) + 8] ? A_[(O_) + 0] : A_[(O_) + 8], l_ = A_[(O_) + 0] > A_[(O_) + 8] ? A_[(O_) + 8] : A_[(O_) + 0]; A_[(O_) + 0] = h_; A_[(O_) + 8] = l_; } { const unsigned h_ = A_[(O_) + 1] > A_[(O_) + 9] ? A_[(O_) + 1] : A_[(O_) + 9], l_ = A_[(O_) + 1] > A_[(O_) + 9] ? A_[(O_) + 9] : A_[(O_) + 1]; A_[(O_) + 1] = h_; A_[(O_) + 9] = l_; } { const unsigned h_ = A_[(O_) + 2] > A_[(O_) + 10] ? A_[(O_) + 2] : A_[(O_) + 10], l_ = A_[(O_) + 2] > A_[(O_) + 10] ? A_[(O_) + 10] : A_[(O_) + 2]; A_[(O_) + 2] = h_; A_[(O_) + 10] = l_; } { const unsigned h_ = A_[(O_) + 3] > A_[(O_) + 11] ? A_[(O_) + 3] : A_[(O_) + 11], l_ = A_[(O_) + 3] > A_[(O_) + 11] ? A_[(O_) + 11] : A_[(O_) + 3]; A_[(O_) + 3] = h_; A_[(O_) + 11] = l_; } { const unsigned h_ = A_[(O_) + 4] > A_[(O_) + 12] ? A_[(O_) + 4] : A_[(O_) + 12], l_ = A_[(O_) + 4] > A_[(O_) + 12] ? A_[(O_) + 12] : A_[(O_) + 4]; A_[(O_) + 4] = h_; A_[(O_) + 12] = l_; } { const unsigned h_ = A_[(O_) + 5] > A_[(O_) + 13] ? A_[(O_) + 5] : A_[(O_) + 13], l_ = A_[(O_) + 5] > A_[(O_) + 13] ? A_[(O_) + 13] : A_[(O_) + 5]; A_[(O_) + 5] = h_; A_[(O_) + 13] = l_; } { const unsigned h_ = A_[(O_) + 6] > A_[(O_) + 14] ? A_[(O_) + 6] : A_[(O_) + 14], l_ = A_[(O_) + 6] > A_[(O_) + 14] ? A_[(O_) + 14] : A_[(O_) + 6]; A_[(O_) + 6] = h_; A_[(O_) + 14] = l_; } { const unsigned h_ = A_[(O_) + 7] > A_[(O_) + 15] ? A_[(O_) + 7] : A_[(O_) + 15], l_ = A_[(O_) + 7] > A_[(O_) + 15] ? A_[(O_) + 15] : A_[(O_) + 7]; A_[(O_) + 7] = h_; A_[(O_) + 15] = l_; } { const unsigned h_ = A_[(O_) + 0] > A_[(O_) + 4] ? A_[(O_) + 0] : A_[(O_) + 4], l_ = A_[(O_) + 0] > A_[(O_) + 4] ? A_[(O_) + 4] : A_[(O_) + 0]; A_[(O_) + 0] = h_; A_[(O_) + 4] = l_; } { const unsigned h_ = A_[(O_) + 1] > A_[(O_) + 5] ? A_[(O_) + 1] : A_[(O_) + 5], l_ = A_[(O_) + 1] > A_[(O_) + 5] ? A_[(O_) + 5] : A_[(O_) + 1]; A_[(O_) + 1] = h_; A_[(O_) + 5] = l_; } { const unsigned h_ = A_[(O_) + 2] > A_[(O_) + 6] ? A_[(O_) + 2] : A_[(O_) + 6], l_ = A_[(O_) + 2] > A_[(O_) + 6] ? A_[(O_) + 6] : A_[(O_) + 2]; A_[(O_) + 2] = h_; A_[(O_) + 6] = l_; } { const unsigned h_ = A_[(O_) + 3] > A_[(O_) + 7] ? A_[(O_) + 3] : A_[(O_) + 7], l_ = A_[(O_) + 3] > A_[(O_) + 7] ? A_[(O_) + 7] : A_[(O_) + 3]; A_[(O_) + 3] = h_; A_[(O_) + 7] = l_; } { const unsigned h_ = A_[(O_) + 8] > A_[(O_) + 12] ? A_[(O_) + 8] : A_[(O_) + 12], l_ = A_[(O_) + 8] > A_[(O_) + 12] ? A_[(O_) + 12] : A_[(O_) + 8]; A_[(O_) + 8] = h_; A_[(O_) + 12] = l_; } { const unsigned h_ = A_[(O_) + 9] > A_[(O_) + 13] ? A_[(O_) + 9] : A_[(O_) + 13], l_ = A_[(O_) + 9] > A_[(O_) + 13] ? A_[(O_) + 13] : A_[(O_) + 9]; A_[(O_) + 9] = h_; A_[(O_) + 13] = l_; } { const unsigned h_ = A_[(O_) + 10] > A_[(O_) + 14] ? A_[(O_) + 10] : A_[(O_) + 14], l_ = A_[(O_) + 10] > A_[(O_) + 14] ? A_[(O_) + 14] : A_[(O_) + 10]; A_[(O_) + 10] = h_; A_[(O_) + 14] = l_; } { const unsigned h_ = A_[(O_) + 11] > A_[(O_) + 15] ? A_[(O_) + 11] : A_[(O_) + 15], l_ = A_[(O_) + 11] > A_[(O_) + 15] ? A_[(O_) + 15] : A_[(O_) + 11]; A_[(O_) + 11] = h_; A_[(O_) + 15] = l_; } { const unsigned h_ = A_[(O_) + 0] > A_[(O_) + 2] ? A_[(O_) + 0] : A_[(O_) + 2], l_ = A_[(O_) + 0] > A_[(O_) + 2] ? A_[(O_) + 2] : A_[(O_) + 0]; A_[(O_) + 0] = h_; A_[(O_) + 2] = l_; } { const unsigned h_ = A_[(O_) + 1] > A_[(O_) + 3] ? A_[(O_) + 1] : A_[(O_) + 3], l_ = A_[(O_) + 1] > A_[(O_) + 3] ? A_[(O_) + 3] : A_[(O_) + 1]; A_[(O_) + 1] = h_; A_[(O_) + 3] = l_; } { const unsigned h_ = A_[(O_) + 4] > A_[(O_) + 6] ? A_[(O_) + 4] : A_[(O_) + 6], l_ = A_[(O_) + 4] > A_[(O_) + 6] ? A_[(O_) + 6] : A_[(O_) + 4]; A_[(O_) + 4] = h_; A_[(O_) + 6] = l_; } { const unsigned h_ = A_[(O_) + 5] > A_[(O_) + 7] ? A_[(O_) + 5] : A_[(O_) + 7], l_ = A_[(O_) + 5] > A_[(O_) + 7] ? A_[(O_) + 7] : A_[(O_) + 5]; A_[(O_) + 5] = h_; A_[(O_) + 7] = l_; } { const unsigned h_ = A_[(O_) + 8] > A_[(O_) + 10] ? A_[(O_) + 8] : A_[(O_) + 10], l_ = A_[(O_) + 8] > A_[(O_) + 10] ? A_[(O_) + 10] : A_[(O_) + 8]; A_[(O_) + 8] = h_; A_[(O_) + 10] = l_; } { const unsigned h_ = A_[(O_) + 9] > A_[(O_) + 11] ? A_[(O_) + 9] : A_[(O_) + 11], l_ = A_[(O_) + 9] > A_[(O_) + 11] ? A_[(O_) + 11] : A_[(O_) + 9]; A_[(O_) + 9] = h_; A_[(O_) + 11] = l_; } { const unsigned h_ = A_[(O_) + 12] > A_[(O_) + 14] ? A_[(O_) + 12] : A_[(O_) + 14], l_ = A_[(O_) + 12] > A_[(O_) + 14] ? A_[(O_) + 14] : A_[(O_) + 12]; A_[(O_) + 12] = h_; A_[(O_) + 14] = l_; } { const unsigned h_ = A_[(O_) + 13] > A_[(O_) + 15] ? A_[(O_) + 13] : A_[(O_) + 15], l_ = A_[(O_) + 13] > A_[(O_) + 15] ? A_[(O_) + 15] : A_[(O_) + 13]; A_[(O_) + 13] = h_; A_[(O_) + 15] = l_; } { const unsigned h_ = A_[(O_) + 0] > A_[(O_) + 1] ? A_[(O_) + 0] : A_[(O_) + 1], l_ = A_[(O_) + 0] > A_[(O_) + 1] ? A_[(O_) + 1] : A_[(O_) + 0]; A_[(O_) + 0] = h_; A_[(O_) + 1] = l_; } { const unsigned h_ = A_[(O_) + 2] > A_[(O_) + 3] ? A_[(O_) + 2] : A_[(O_) + 3], l_ = A_[(O_) + 2] > A_[(O_) + 3] ? A_[(O_) + 3] : A_[(O_) + 2]; A_[(O_) + 2] = h_; A_[(O_) + 3] = l_; } { const unsigned h_ = A_[(O_) + 4] > A_[(O_) + 5] ? A_[(O_) + 4] : A_[(O_) + 5], l_ = A_[(O_) + 4] > A_[(O_) + 5] ? A_[(O_) + 5] : A_[(O_) + 4]; A_[(O_) + 4] = h_; A_[(O_) + 5] = l_; } { const unsigned h_ = A_[(O_) + 6] > A_[(O_) + 7] ? A_[(O_) + 6] : A_[(O_) + 7], l_ = A_[(O_) + 6] > A_[(O_) + 7] ? A_[(O_) + 7] : A_[(O_) + 6]; A_[(O_) + 6] = h_; A_[(O_) + 7] = l_; } { const unsigned h_ = A_[(O_) + 8] > A_[(O_) + 9] ? A_[(O_) + 8] : A_[(O_) + 9], l_ = A_[(O_) + 8] > A_[(O_) + 9] ? A_[(O_) + 9] : A_[(O_) + 8]; A_[(O_) + 8] = h_; A_[(O_) + 9] = l_; } { const unsigned h_ = A_[(O_) + 10] > A_[(O_) + 11] ? A_[(O_) + 10] : A_[(O_) + 11], l_ = A_[(O_) + 10] > A_[(O_) + 11] ? A_[(O_) + 11] : A_[(O_) + 10]; A_[(O_) + 10] = h_; A_[(O_) + 11] = l_; } { const unsigned h_ = A_[(O_) + 12] > A_[(O_) + 13] ? A_[(O_) + 12] : A_[(O_) + 13], l_ = A_[(O_) + 12] > A_[(O_) + 13] ? A_[(O_) + 13] : A_[(O_) + 12]; A_[(O_) + 12] = h_; A_[(O_) + 13] = l_; } { const unsigned h_ = A_[(O_) + 14] > A_[(O_) + 15] ? A_[(O_) + 14] : A_[(O_) + 15], l_ = A_[(O_) + 14] > A_[(O_) + 15] ? A_[(O_) + 15] : A_[(O_) + 14]; A_[(O_) + 14] = h_; A_[(O_) + 15] = l_; } } while (0)
#define MERGE16(T_) do { { const unsigned h_ = T_[0] > T_[8] ? T_[0] : T_[8], l_ = T_[0] > T_[8] ? T_[8] : T_[0]; T_[0] = h_; T_[8] = l_; } { const unsigned h_ = T_[1] > T_[9] ? T_[1] : T_[9], l_ = T_[1] > T_[9] ? T_[9] : T_[1]; T_[1] = h_; T_[9] = l_; } { const unsigned h_ = T_[2] > T_[10] ? T_[2] : T_[10], l_ = T_[2] > T_[10] ? T_[10] : T_[2]; T_[2] = h_; T_[10] = l_; } { const unsigned h_ = T_[3] > T_[11] ? T_[3] : T_[11], l_ = T_[3] > T_[11] ? T_[11] : T_[3]; T_[3] = h_; T_[11] = l_; } { const unsigned h_ = T_[4] > T_[12] ? T_[4] : T_[12], l_ = T_[4] > T_[12] ? T_[12] : T_[4]; T_[4] = h_; T_[12] = l_; } { const unsigned h_ = T_[5] > T_[13] ? T_[5] : T_[13], l_ = T_[5] > T_[13] ? T_[13] : T_[5]; T_[5] = h_; T_[13] = l_; } { const unsigned h_ = T_[6] > T_[14] ? T_[6] : T_[14], l_ = T_[6] > T_[14] ? T_[14] : T_[6]; T_[6] = h_; T_[14] = l_; } { const unsigned h_ = T_[7] > T_[15] ? T_[7] : T_[15], l_ = T_[7] > T_[15] ? T_[15] : T_[7]; T_[7] = h_; T_[15] = l_; } { const unsigned h_ = T_[0] > T_[4] ? T_[0] : T_[4], l_ = T_[0] > T_[4] ? T_[4] : T_[0]; T_[0] = h_; T_[4] = l_; } { const unsigned h_ = T_[1] > T_[5] ? T_[1] : T_[5], l_ = T_[1] > T_[5] ? T_[5] : T_[1]; T_[1] = h_; T_[5] = l_; } { const unsigned h_ = T_[2] > T_[6] ? T_[2] : T_[6], l_ = T_[2] > T_[6] ? T_[6] : T_[2]; T_[2] = h_; T_[6] = l_; } { const unsigned h_ = T_[3] > T_[7] ? T_[3] : T_[7], l_ = T_[3] > T_[7] ? T_[7] : T_[3]; T_[3] = h_; T_[7] = l_; } { const unsigned h_ = T_[8] > T_[12] ? T_[8] : T_[12], l_ = T_[8] > T_[12] ? T_[12] : T_[8]; T_[8] = h_; T_[12] = l_; } { const unsigned h_ = T_[9] > T_[13] ? T_[9] : T_[13], l_ = T_[9] > T_[13] ? T_[13] : T_[9]; T_[9] = h_; T_[13] = l_; } { const unsigned h_ = T_[10] > T_[14] ? T_[10] : T_[14], l_ = T_[10] > T_[14] ? T_[14] : T_[10]; T_[10] = h_; T_[14] = l_; } { const unsigned h_ = T_[11] > T_[15] ? T_[11] : T_[15], l_ = T_[11] > T_[15] ? T_[15] : T_[11]; T_[11] = h_; T_[15] = l_; } { const unsigned h_ = T_[0] > T_[2] ? T_[0] : T_[2], l_ = T_[0] > T_[2] ? T_[2] : T_[0]; T_[0] = h_; T_[2] = l_; } { const unsigned h_ = T_[1] > T_[3] ? T_[1] : T_[3], l_ = T_[1] > T_[3] ? T_[3] : T_[1]; T_[1] = h_; T_[3] = l_; } { const unsigned h_ = T_[4] > T_[6] ? T_[4] : T_[6], l_ = T_[4] > T_[6] ? T_[6] : T_[4]; T_[4] = h_; T_[6] = l_; } { const unsigned h_ = T_[5] > T_[7] ? T_[5] : T_[7], l_ = T_[5] > T_[7] ? T_[7] : T_[5]; T_[5] = h_; T_[7] = l_; } { const unsigned h_ = T_[8] > T_[10] ? T_[8] : T_[10], l_ = T_[8] > T_[10] ? T_[10] : T_[8]; T_[8] = h_; T_[10] = l_; } { const unsigned h_ = T_[9] > T_[11] ? T_[9] : T_[11], l_ = T_[9] > T_[11] ? T_[11] : T_[9]; T_[9] = h_; T_[11] = l_; } { const unsigned h_ = T_[12] > T_[14] ? T_[12] : T_[14], l_ = T_[12] > T_[14] ? T_[14] : T_[12]; T_[12] = h_; T_[14] = l_; } { const unsigned h_ = T_[13] > T_[15] ? T_[13] : T_[15], l_ = T_[13] > T_[15] ? T_[15] : T_[13]; T_[13] = h_; T_[15] = l_; } { const unsigned h_ = T_[0] > T_[1] ? T_[0] : T_[1], l_ = T_[0] > T_[1] ? T_[1] : T_[0]; T_[0] = h_; T_[1] = l_; } { const unsigned h_ = T_[2] > T_[3] ? T_[2] : T_[3], l_ = T_[2] > T_[3] ? T_[3] : T_[2]; T_[2] = h_; T_[3] = l_; } { const unsigned h_ = T_[4] > T_[5] ? T_[4] : T_[5], l_ = T_[4] > T_[5] ? T_[5] : T_[4]; T_[4] = h_; T_[5] = l_; } { const unsigned h_ = T_[6] > T_[7] ? T_[6] : T_[7], l_ = T_[6] > T_[7] ? T_[7] : T_[6]; T_[6] = h_; T_[7] = l_; } { const unsigned h_ = T_[8] > T_[9] ? T_[8] : T_[9], l_ = T_[8] > T_[9] ? T_[9] : T_[8]; T_[8] = h_; T_[9] = l_; } { const unsigned h_ = T_[10] > T_[11] ? T_[10] : T_[11], l_ = T_[10] > T_[11] ? T_[11] : T_[10]; T_[10] = h_; T_[11] = l_; } { const unsigned h_ = T_[12] > T_[13] ? T_[12] : T_[13], l_ = T_[12] > T_[13] ? T_[13] : T_[12]; T_[12] = h_; T_[13] = l_; } { const unsigned h_ = T_[14] > T_[15] ? T_[14] : T_[15], l_ = T_[14] > T_[15] ? T_[15] : T_[14]; T_[14] = h_; T_[15] = l_; } } while (0)

namespace peer {
__device__ __forceinline__ unsigned f2ord(float f) { const unsigned u = __builtin_bit_cast(unsigned, f); return u ^ ((unsigned)((int)u >> 31) | 0x80000000u); }
__device__ __forceinline__ float ord2f(unsigned o) { const unsigned u = (o & 0x80000000u) ? (o ^ 0x80000000u) : ~o; return __builtin_bit_cast(float, u); }
__device__ __forceinline__ unsigned pair_max(unsigned v) { auto rr = __builtin_amdgcn_permlane32_swap(v, v, false, false); return rr[0] > rr[1] ? rr[0] : rr[1]; }

constexpr int SKP = 136;
template <int C_> __device__ __forceinline__ void route_half(int r32, int hi, int tok0, int h, const bf16_t* __restrict__ PQ, const LAS bf16_t* skl, unsigned (&kt)[16]) {
    const LAS bf16_t* skb = skl + C_ * 128 * SKP;
    f32x16 acc[4] = {};
    const bf16_t* qrow = PQ + (size_t)(tok0 + r32) * DM + (h * 2 + C_) * 128 + 8 * hi;
    bf16x8 bq[8];
#pragma unroll
    for (int t = 0; t < 8; ++t) bq[t] = *(const bf16x8*)(qrow + 16 * t);
#pragma unroll
    for (int t = 0; t < 8; ++t) {
#pragma unroll
        for (int kq = 0; kq < 4; ++kq) { const bf16x8 a = *(const LAS bf16x8*)(skb + (32 * kq + r32) * SKP + 16 * t + 8 * hi);
            acc[kq] = __builtin_amdgcn_mfma_f32_32x32x16_bf16(a, bq[t], acc[kq], 0, 0, 0); }
    }
    unsigned key[64];
#pragma unroll
    for (int kq = 0; kq < 4; ++kq)
#pragma unroll
        for (int r = 0; r < 16; ++r) key[kq * 16 + r] = (f2ord(acc[kq][r]) & ~127u) | (unsigned)(127 - (32 * kq + (r & 3) + 8 * (r >> 2)) - 4 * hi);
    SORT16(key, 0); SORT16(key, 16); SORT16(key, 32); SORT16(key, 48);
    unsigned t0[16], t1[16];
#pragma unroll
    for (int i = 0; i < 16; ++i) { t0[i] = key[i] > key[31 - i] ? key[i] : key[31 - i]; t1[i] = key[32 + i] > key[63 - i] ? key[32 + i] : key[63 - i]; }
    MERGE16(t0); MERGE16(t1);
#pragma unroll
    for (int i = 0; i < 16; ++i) t0[i] = t0[i] > t1[15 - i] ? t0[i] : t1[15 - i];
    MERGE16(t0);
#pragma unroll
    for (int i = 0; i < 16; ++i) { const unsigned u = t0[15 - i]; auto rr = __builtin_amdgcn_permlane32_swap(u, u, false, false); const unsigned pu = hi ? rr[0] : rr[1];
        kt[i] = t0[i] > pu ? t0[i] : pu; }
    MERGE16(kt);
}
__device__ __forceinline__ void route_unit(int lane, int tok0, int h, const bf16_t* __restrict__ PQ, const LAS bf16_t* SK, int* __restrict__ experts, float* __restrict__ pgates, LAS unsigned* rt) {
    const int r32 = lane & 31, hi = lane >> 5;
    unsigned kt0[16], kt1[16];
    route_half<0>(r32, hi, tok0, h, PQ, SK, kt0); SBAR();
    route_half<1>(r32, hi, tok0, h, PQ, SK, kt1); SBAR();
    unsigned ck[64];
    { int n = 0;
#pragma unroll
      for (int a = 0; a < 16; ++a)
#pragma unroll
        for (int b = 0; b < 16; ++b) if ((a + 1) * (b + 1) <= 16) { ck[n] = (f2ord(ord2f(kt0[a] & ~127u) + ord2f(kt1[b] & ~127u)) & ~255u) | (unsigned)(255 - (a * 16 + b)); ++n; }
#pragma unroll
      for (int z = 50; z < 64; ++z) ck[z] = 0u; }
    SBAR();
    SORT16(ck, 0); SORT16(ck, 16); SORT16(ck, 32); SORT16(ck, 48);
    unsigned c0[16], c1[16];
#pragma unroll
    for (int i = 0; i < 16; ++i) { c0[i] = ck[i] > ck[31 - i] ? ck[i] : ck[31 - i]; c1[i] = ck[32 + i] > ck[63 - i] ? ck[32 + i] : ck[63 - i]; }
    MERGE16(c0); MERGE16(c1);
#pragma unroll
    for (int i = 0; i < 16; ++i) c0[i] = c0[i] > c1[15 - i] ? c0[i] : c1[15 - i];
    MERGE16(c0);
#pragma unroll
    for (int a = 0; a < 16; ++a) { rt[a * 64 + lane] = kt0[a]; rt[(16 + a) * 64 + lane] = kt1[a]; }
    float bs[16]; int be[16];
#pragma unroll
    for (int p = 0; p < 16; ++p) { const unsigned best = c0[p];
        const int flat = 255 - (int)(best & 255u), ia = flat >> 4, ib = flat & 15;
        const unsigned ka = rt[ia * 64 + lane], kb = rt[(16 + ib) * 64 + lane];
        bs[p] = ord2f(best & ~255u); be[p] = (127 - (int)(ka & 127u)) * 128 + (127 - (int)(kb & 127u)); }
    float es[16]; float sum = 0.f;
#pragma unroll
    for (int p = 0; p < 16; ++p) { es[p] = __expf(bs[p] - bs[0]); sum += es[p]; }
    const float inv = 1.0f / sum;
    if (hi == 0) { int* ep = experts + (size_t)(tok0 + r32) * 128 + h * 16;
#pragma unroll
        for (int g = 0; g < 4; ++g) *(int4*)(ep + 4 * g) = make_int4(be[4 * g], be[4 * g + 1], be[4 * g + 2], be[4 * g + 3]);
    } else { float* gp = pgates + (size_t)(tok0 + r32) * 128 + h * 16;
#pragma unroll
        for (int g = 0; g < 4; ++g) *(f32x4*)(gp + 4 * g) = (f32x4){es[4 * g] * inv, es[4 * g + 1] * inv, es[4 * g + 2] * inv, es[4 * g + 3] * inv}; }
}

__device__ __forceinline__ float gelu_exact(float v) { return 0.5f * v * (1.0f + erff(v * 0.70710678118654752f)); }

__device__ __forceinline__ unsigned fp6_code(float y) {
    const float a = fabsf(y);
    const float mult = a < 2.0f ? 8.0f : (a < 4.0f ? 4.0f : 2.0f); const unsigned base = a < 2.0f ? 0u : (a < 4.0f ? 8u : 16u);
    unsigned c = base + (unsigned)__builtin_rintf(a * mult); c = c > 31u ? 31u : c;
    return c | ((__builtin_bit_cast(unsigned, y) >> 31) << 5);
}
typedef unsigned u32x6 __attribute__((ext_vector_type(6)));
typedef float f32x32 __attribute__((ext_vector_type(32)));
__device__ __forceinline__ void quant_row_fp6(int lane, const float* __restrict__ src, unsigned char* __restrict__ dst, float* __restrict__ scale_out) {
    f32x4 v[8]; float am = 0.f;
#pragma unroll
    for (int j = 0; j < 8; ++j) { v[j] = *(const f32x4*)(src + 256 * j + 4 * lane);
        am = fmaxf(am, fmaxf(fmaxf(fabsf(v[j][0]), fabsf(v[j][1])), fmaxf(fabsf(v[j][2]), fabsf(v[j][3])))); }
    am = wave_max(am);
    const float sc = am > 0.f ? 7.5f / am : 1.0f;
    if (lane == 0) *scale_out = am > 0.f ? am * (1.0f / 7.5f) : 1.0f;
    unsigned long long lo = 0ull, mid = 0ull, hi = 0ull;
    unsigned w[6] = {0u, 0u, 0u, 0u, 0u, 0u};
#pragma unroll
    for (int e = 0; e < 32; ++e) { const unsigned c = fp6_code(v[e >> 2][e & 3] * sc); const int bit = 6 * e, d = bit >> 5, sh = bit & 31;
        w[d] |= c << sh; if (sh > 26) w[d + 1] |= c >> (32 - sh); }
    (void)lo; (void)mid; (void)hi;
    *(u32x4*)(dst + 16 * lane) = (u32x4){w[0], w[1], w[2], w[3]};
    *(u32x2*)(dst + 1024 + 8 * lane) = (u32x2){w[4], w[5]};
}

__device__ __forceinline__ unsigned fp4_code(float y) { const float a = fabsf(y);
    const unsigned idx = (unsigned)(a > 0.25f) + (unsigned)(a > 0.75f) + (unsigned)(a > 1.25f) + (unsigned)(a > 1.75f) + (unsigned)(a > 2.5f) + (unsigned)(a > 3.5f) + (unsigned)(a > 5.0f);
    return idx | ((__builtin_bit_cast(unsigned, y) >> 31) << 3); }
__device__ __forceinline__ void quant_row_fp4(int lane, const float* __restrict__ src, unsigned char* __restrict__ dst, float* __restrict__ scale_out) {
    f32x4 v[8]; float am = 0.f;
#pragma unroll
    for (int j = 0; j < 8; ++j) { v[j] = *(const f32x4*)(src + 256 * j + 4 * lane);
        am = fmaxf(am, fmaxf(fmaxf(fabsf(v[j][0]), fabsf(v[j][1])), fmaxf(fabsf(v[j][2]), fabsf(v[j][3])))); }
    am = wave_max(am);
    const float sc = am > 0.f ? 6.0f / am : 1.0f;
    if (lane == 0) *scale_out = am > 0.f ? am * (1.0f / 6.0f) : 1.0f;
    unsigned w[4] = {0u, 0u, 0u, 0u};
#pragma unroll
    for (int e = 0; e < 32; ++e) w[e >> 3] |= fp4_code(v[e >> 2][e & 3] * sc) << (4 * (e & 7));
    *(u32x4*)(dst + 16 * lane) = (u32x4){w[0], w[1], w[2], w[3]};
}
__device__ __forceinline__ void quant_rows2_fp4(int lane, const float* __restrict__ s0, const float* __restrict__ s1, unsigned char* __restrict__ d0, unsigned char* __restrict__ d1, float* __restrict__ sc0, float* __restrict__ sc1) {
    f32x4 v[2][8]; float am[2] = {0.f, 0.f};
#pragma unroll
    for (int j = 0; j < 8; ++j) { v[0][j] = __builtin_nontemporal_load((const f32x4*)(s0 + 256 * j + 4 * lane)); v[1][j] = __builtin_nontemporal_load((const f32x4*)(s1 + 256 * j + 4 * lane)); }
#pragma unroll
    for (int r = 0; r < 2; ++r)
#pragma unroll
        for (int j = 0; j < 8; ++j) am[r] = fmaxf(am[r], fmaxf(fmaxf(fabsf(v[r][j][0]), fabsf(v[r][j][1])), fmaxf(fabsf(v[r][j][2]), fabsf(v[r][j][3]))));
#pragma unroll
    for (int o = 1; o < 64; o <<= 1) { am[0] = fmaxf(am[0], __shfl_xor(am[0], o)); am[1] = fmaxf(am[1], __shfl_xor(am[1], o)); }
#pragma unroll
    for (int r = 0; r < 2; ++r) { const float sc = am[r] > 0.f ? 6.0f / am[r] : 1.0f;
        if (lane == 0) *(r ? sc1 : sc0) = am[r] > 0.f ? am[r] * (1.0f / 6.0f) : 1.0f;
        unsigned w[4] = {0u, 0u, 0u, 0u};
#define QP_(d_, b_) w[d_] = __builtin_amdgcn_cvt_scalef32_pk_fp4_f32(w[d_], v[r][2 * (d_) + ((b_) >> 1)][2 * ((b_) & 1)] * sc, v[r][2 * (d_) + ((b_) >> 1)][2 * ((b_) & 1) + 1] * sc, 1.0f, b_)
#define QD_(d_) QP_(d_, 0); QP_(d_, 1); QP_(d_, 2); QP_(d_, 3)
        QD_(0); QD_(1); QD_(2); QD_(3);
#undef QD_
#undef QP_
        *(u32x4*)((r ? d1 : d0) + 16 * lane) = (u32x4){w[0], w[1], w[2], w[3]}; }
}

__device__ __forceinline__ float dpp_total(float v) {
#define DPPADD(ctrl, rmask) v += __builtin_bit_cast(float, __builtin_amdgcn_update_dpp(0, __builtin_bit_cast(int, v), ctrl, rmask, 0xf, true))
    DPPADD(0xB1, 0xf); DPPADD(0x4E, 0xf); DPPADD(0x141, 0xf); DPPADD(0x140, 0xf); DPPADD(0x142, 0xa); DPPADD(0x143, 0xc);
#undef DPPADD
    return __builtin_bit_cast(float, __builtin_amdgcn_readlane(__builtin_bit_cast(int, v), 63));
}
#ifndef PEER_FP4
#define PEER_FP4 1
#endif
#if PEER_FP4
constexpr int ROWB = 1024;
struct Row6 { u32x4 a; };
#define LOADROW(W_, TAB_, i_) do { const int e_ = __builtin_amdgcn_readlane((i_) < 64 ? ev0 : ev1, (i_) & 63); W_.a = *(const u32x4*)((TAB_) + (size_t)e_ * ROWB + 16 * lane); } while (0)
struct F2x16 { f32x2 p[16]; };
__device__ __forceinline__ F2x16 dec32_fp4(const u32x4 w) { F2x16 f;
#pragma unroll
    for (int d = 0; d < 4; ++d) { f.p[4 * d] = __builtin_amdgcn_cvt_scalef32_pk_f32_fp4(w[d], 1.0f, 0); f.p[4 * d + 1] = __builtin_amdgcn_cvt_scalef32_pk_f32_fp4(w[d], 1.0f, 1);
        f.p[4 * d + 2] = __builtin_amdgcn_cvt_scalef32_pk_f32_fp4(w[d], 1.0f, 2); f.p[4 * d + 3] = __builtin_amdgcn_cvt_scalef32_pk_f32_fp4(w[d], 1.0f, 3); }
    return f; }
#define DEC32(W_) dec32_fp4(W_.a)
#else
constexpr int ROWB = 1536;
struct Row6 { u32x4 a; u32x2 b; };
#define LOADROW(W_, TAB_, i_) do { const int e_ = __builtin_amdgcn_readlane((i_) < 64 ? ev0 : ev1, (i_) & 63); const unsigned char* p_ = (TAB_) + (size_t)e_ * ROWB; \
        W_.a = *(const u32x4*)(p_ + 16 * lane); W_.b = *(const u32x2*)(p_ + 1024 + 8 * lane); } while (0)
struct F2x16 { f32x2 p[16]; };
__device__ __forceinline__ F2x16 dec32_fp6(const u32x4 a, const u32x2 b) { const f32x32 v = __builtin_amdgcn_cvt_scalef32_pk32_f32_fp6((u32x6){a[0], a[1], a[2], a[3], b[0], b[1]}, 1.0f); F2x16 f;
#pragma unroll
    for (int i = 0; i < 16; ++i) f.p[i] = (f32x2){v[2 * i], v[2 * i + 1]};
    return f; }
#define DEC32(W_) dec32_fp6(W_.a, W_.b)
#endif
__device__ __forceinline__ void gather_token(int lane_in, int tok, const f32x2* __restrict__ ST, const float* __restrict__ g2, const float* __restrict__ b2, const bf16_t* __restrict__ ZB, float* XO, const unsigned char* __restrict__ U8, const unsigned char* __restrict__ V8,
                                             const float* __restrict__ USC, const float* __restrict__ VSC, const int* __restrict__ experts, const float* __restrict__ pgates,
                                             const float* __restrict__ g3, const float* __restrict__ b3) {
    int lane = lane_in; asm volatile("" : "+v"(lane));
    f32x2 xr[16];
    { const f32x2 pp = lane < 32 ? ST[(size_t)tok * 32 + lane] : (f32x2){0.f, 0.f}; const f32x2 pv = {wave_sum(pp[0]), wave_sum(pp[1])}; const float mean = pv[0] * (1.f / DM); const float rstd = 1.f / sqrtf(fmaxf(pv[1] * (1.f / DM) - mean * mean, 0.f) + LN_EPS);
#pragma unroll
      for (int j = 0; j < 8; ++j) { const int c0 = 256 * j + 4 * lane; const u32x2 zw = __builtin_nontemporal_load((const u32x2*)(ZB + (size_t)tok * DM + c0)); const f32x4 gg = *(const f32x4*)(g2 + c0), bb = *(const f32x4*)(b2 + c0);
        xr[2 * j] = (f32x2){(bflo(zw[0]) - mean) * rstd * gg[0] + bb[0], (bfhi(zw[0]) - mean) * rstd * gg[1] + bb[1]};
        xr[2 * j + 1] = (f32x2){(bflo(zw[1]) - mean) * rstd * gg[2] + bb[2], (bfhi(zw[1]) - mean) * rstd * gg[3] + bb[3]}; } }
    const int ev0 = experts[(size_t)tok * 128 + lane], ev1 = experts[(size_t)tok * 128 + 64 + lane];
    float sv0 = 0.f, sv1 = 0.f;
    Row6 wA[4], wB[4];
#define UPART(W_, P_) do { const F2x16 f = DEC32(W_); f32x2 sa_ = {0.f, 0.f}, sb_ = {0.f, 0.f}; _Pragma("unroll") for (int e_ = 0; e_ < 16; e_ += 2) { sa_ = __builtin_elementwise_fma(f.p[e_], xr[e_], sa_); sb_ = __builtin_elementwise_fma(f.p[e_ + 1], xr[e_ + 1], sb_); } \
        sa_ += sb_; P_ = sa_[0] + sa_[1]; SBAR(); } while (0)
#define DPPF(v, ctrl, rm, bm) __builtin_bit_cast(float, __builtin_amdgcn_update_dpp(0, __builtin_bit_cast(int, (float)(v)), ctrl, rm, bm, false))
    const bool lb0 = lane & 1, lb1 = lane & 2, lb2 = lane & 4; const int lgrp = lane >> 3;
    float ps[8];
#pragma unroll
    for (int q = 0; q < 4; ++q) LOADROW(wA[q], U8, q);
#pragma unroll 1
    for (int i0 = 0; i0 < 128; i0 += 8) {
#pragma unroll
        for (int q = 0; q < 4; ++q) LOADROW(wB[q], U8, i0 + 4 + q);
        SBAR();
#pragma unroll
        for (int q = 0; q < 4; ++q) UPART(wA[q], ps[q]);
        if (i0 + 8 < 128) {
#pragma unroll
            for (int q = 0; q < 4; ++q) LOADROW(wA[q], U8, i0 + 8 + q); }
        SBAR();
#pragma unroll
        for (int q = 0; q < 4; ++q) UPART(wB[q], ps[4 + q]);
        float t1[4], t2[2];
#pragma unroll
        for (int k = 0; k < 4; ++k) { const float keep = lb0 ? ps[2 * k + 1] : ps[2 * k], send = lb0 ? ps[2 * k] : ps[2 * k + 1]; t1[k] = keep + DPPF(send, 0xB1, 0xf, 0xf); }
#pragma unroll
        for (int m = 0; m < 2; ++m) { const float keep = lb1 ? t1[2 * m + 1] : t1[2 * m], send = lb1 ? t1[2 * m] : t1[2 * m + 1]; t2[m] = keep + DPPF(send, 0x4E, 0xf, 0xf); }
        float rr; { const float keep = lb2 ? t2[1] : t2[0], send = lb2 ? t2[0] : t2[1]; rr = keep + DPPF(send, 0x104, 0xf, 0x5) + DPPF(send, 0x114, 0xf, 0xa); }
        rr += DPPF(rr, 0x128, 0xf, 0xf);
        { auto s16 = __builtin_amdgcn_permlane16_swap(__float_as_uint(rr), __float_as_uint(rr), false, false); rr = __uint_as_float(s16[0]) + __uint_as_float(s16[1]); }
        { auto s32 = __builtin_amdgcn_permlane32_swap(__float_as_uint(rr), __float_as_uint(rr), false, false); rr = __uint_as_float(s32[0]) + __uint_as_float(s32[1]); }
        const bool mine = lgrp == ((i0 >> 3) & 7);
        if (i0 < 64) sv0 = mine ? rr : sv0; else sv1 = mine ? rr : sv1;
        SBAR();
    }
#undef UPART
#undef DPPF
    const float av0 = gelu_exact(sv0 * USC[ev0]) * pgates[(size_t)tok * 128 + lane] * VSC[ev0];
    const float av1 = gelu_exact(sv1 * USC[ev1]) * pgates[(size_t)tok * 128 + 64 + lane] * VSC[ev1];
    f32x2 acc2[16];
#pragma unroll
    for (int e = 0; e < 16; ++e) acc2[e] = (f32x2){0.f, 0.f};
#define VROW(W_, i_) do { const float a_ = __builtin_bit_cast(float, __builtin_amdgcn_readlane(__builtin_bit_cast(int, (i_) < 64 ? av0 : av1), (i_) & 63)); \
        const F2x16 f = DEC32(W_); const f32x2 a2_ = {a_, a_}; _Pragma("unroll") for (int e_ = 0; e_ < 16; ++e_) acc2[e_] = __builtin_elementwise_fma(f.p[e_], a2_, acc2[e_]); SBAR(); } while (0)
#pragma unroll
    for (int q = 0; q < 4; ++q) LOADROW(wA[q], V8, q);
#pragma unroll 1
    for (int i0 = 0; i0 < 128; i0 += 8) {
#pragma unroll
        for (int q = 0; q < 4; ++q) LOADROW(wB[q], V8, i0 + 4 + q);
        SBAR();
#pragma unroll
        for (int q = 0; q < 4; ++q) VROW(wA[q], i0 + q);
        if (i0 + 8 < 128) {
#pragma unroll
            for (int q = 0; q < 4; ++q) LOADROW(wA[q], V8, i0 + 8 + q); }
        SBAR();
#pragma unroll
        for (int q = 0; q < 4; ++q) VROW(wB[q], i0 + 4 + q);
    }
#undef VROW
    asm volatile("" : "+v"(lane) :: "memory");
    float* orow = XO + (size_t)tok * DM; float s = 0.f; float acc[32];
#pragma unroll
    for (int e = 0; e < 16; ++e) { acc[2 * e] = acc2[e][0] + ALPHA * xr[e][0]; acc[2 * e + 1] = acc2[e][1] + ALPHA * xr[e][1]; s += acc[2 * e] + acc[2 * e + 1]; }
    const float mean = wave_sum(s) * (1.f / DM); float s2 = 0.f;
#pragma unroll
    for (int e = 0; e < 32; ++e) { acc[e] -= mean; s2 += acc[e] * acc[e]; }
    const float rstd = 1.f / sqrtf(wave_sum(s2) * (1.f / DM) + LN_EPS);
#pragma unroll
    for (int j = 0; j < 8; ++j) { const int c0 = 256 * j + 4 * lane;
        const f32x4 ga = *(const f32x4*)(g3 + c0), ba = *(const f32x4*)(b3 + c0); f32x4 oa;
#pragma unroll
        for (int e = 0; e < 4; ++e) oa[e] = acc[4 * j + e] * rstd * ga[e] + ba[e];
        __builtin_nontemporal_store(oa, (f32x4*)(orow + c0)); }
}
#undef DEC32
#undef LOADROW
}

#if PEER_FP4
#define PEER_QUANT peer::quant_row_fp4
#else
#define PEER_QUANT peer::quant_row_fp6
#endif
#ifndef MK_ONE_LAUNCH
#define MK_ONE_LAUNCH 1
#endif
#ifndef MK_DUP
#define MK_DUP 0
#endif
#define DUP(b) ((MK_DUP >> (b)) & 1)
#ifndef MK_CG_SYNC
#define MK_CG_SYNC 0
#endif
constexpr int NPH = 16;
struct Args { GAS const float* in[23]; GAS float* out; GAS unsigned char* ws; int ph_lo, ph_hi; };
typedef const __attribute__((address_space(4))) Args* ArgsP;
__device__ __forceinline__ ArgsP get_args() { size_t z = 0; asm volatile("" : "+s"(z)); return (ArgsP)((const __attribute__((address_space(4))) char*)__builtin_amdgcn_kernarg_segment_ptr() + z); }
#define AIN(i) ((const float*)A->in[i])
#define AOUT ((float*)A->out)
enum { I_X = 0, I_MEM, I_WIN, I_BIG, I_BFG, I_AQN, I_AKN, I_MLN, I_WOUT, I_LN1G, I_LN1B, I_XWQ, I_XWK, I_XWV, I_XWO, I_LN2G, I_LN2B, I_PWQ, I_PSK, I_PU, I_PV, I_LN3G, I_LN3B };

struct SGemmOrder {
    const bf16_t* Q2; const bf16_t* K2; int G, c;
    __device__ bool next(int i, pg8::Unit& u) const { const int L = i * G + c; if (L >= 256) return false; u.pm = L >> 2; u.pn = L & 3;
        u.a = (const char*)(Q2 + (size_t)u.pm * 256 * DM + u.pn * 512); u.b = (const char*)(K2 + (size_t)(u.pm >> 4) * 256 * DM + u.pn * 512); return true; }
};
struct PVGemmOrder {
    const bf16_t* P; const bf16_t* V2T; int G, c;
    __device__ bool next(int i, pg8::Unit& u) const { const int L = i * G + c; if (L >= 512) return false; u.pm = L >> 3; u.pn = L & 7;
        u.a = (const char*)(P + (size_t)u.pm * 256 * 1024 + (u.pn >> 1) * 256); u.b = (const char*)(V2T + (size_t)u.pn * 256 * 1024 + (u.pm >> 4) * 256); return true; }
};

__device__ __forceinline__ unsigned lane_now() { unsigned z0 = 0u; asm volatile("" : "+v"(z0)); return __builtin_amdgcn_mbcnt_hi(~0u, __builtin_amdgcn_mbcnt_lo(~0u, z0)); }
__device__ __forceinline__ Ctx mk_ctx(unsigned char* lds_raw, int wave_s) {
    Ctx C; int wv = wave_s; asm volatile("" : "+s"(wv));
    unsigned z0 = 0u; asm volatile("" : "+v"(z0));
    int tid = wv * 64 + (int)__builtin_amdgcn_mbcnt_hi(~0u, __builtin_amdgcn_mbcnt_lo(~0u, z0)); asm volatile("" : "+v"(tid));
    int bx = blockIdx.x; asm volatile("" : "+s"(bx)); int G = gridDim.x; asm volatile("" : "+s"(G));
    C.lds = (LAS unsigned char*)lds_raw; C.tid = tid; C.lane = tid & 63; C.wave = wv;
    C.G = G; C.vcu = (G % 8 == 0) ? (bx % 8) * (G / 8) + bx / 8 : bx; C.bx = bx;
    C.gw = C.vcu * NWAVES + C.wave; C.NGW = G * NWAVES; return C;
}
#define WSP(T, off) ((T*)(ws + (off)))

__device__ __forceinline__ void phase0(unsigned char* lds_raw, int wave_s) {
    const Ctx C = mk_ctx(lds_raw, wave_s); const ArgsP A = get_args(); unsigned char* ws = (unsigned char*)A->ws;
    LAS float* scr = (LAS float*)(C.lds + C.wave * 16384);
    constexpr int I_W = 32 * 152, I_S = 32 * 64;
#if PEER_FP4
    for (int e = C.gw; e < NEXP; e += C.NGW)
        peer::quant_rows2_fp4(C.lane, AIN(I_PU) + (size_t)e * DM, AIN(I_PV) + (size_t)e * DM, WSP(unsigned char, WS_UB) + (size_t)e * peer::ROWB, WSP(unsigned char, WS_VB) + (size_t)e * peer::ROWB, WSP(float, WS_USC) + e, WSP(float, WS_VSC) + e);
#else
    for (int r = C.gw; r < 2 * NEXP; r += C.NGW) { const int isv = r >= NEXP, e = isv ? r - NEXP : r;
        PEER_QUANT(C.lane, AIN(isv ? I_PV : I_PU) + (size_t)e * DM, WSP(unsigned char, isv ? WS_VB : WS_UB) + (size_t)e * peer::ROWB, WSP(float, isv ? WS_VSC : WS_USC) + e); }
#endif
    for (int it = C.gw; it < I_W + 6 * I_S; it += C.NGW) {
        int r = it;
        if (r < I_W) { p0_transpose_item(AIN(I_WIN), DM, IN_TOTAL, WSP(bf16_t, WS_WIN), scr, r, 152, C.lane); continue; } r -= I_W;
        const int which = r / I_S; r -= which * I_S;
        const float* W = which == 0 ? AIN(I_WOUT) : which == 1 ? AIN(I_XWQ) : which == 2 ? AIN(I_XWK) : which == 3 ? AIN(I_XWV) : which == 4 ? AIN(I_XWO) : AIN(I_PWQ);
        bf16_t* WT = WSP(bf16_t, WS_WOUT + (size_t)which * 8 * MiB);
        if (which == 1) p0_transpose_item(W, DM, DM, WT, scr, r, 64, C.lane, AIN(I_LN1G), AIN(I_LN1B), WSP(float, WS_CSP), WSP(float, WS_CSP + 262144), WSP(bf16_t, WS_WQN));
        else if (which == 5) p0_transpose_item(W, DM, DM, WT, scr, r, 64, C.lane, AIN(I_LN2G), AIN(I_LN2B), WSP(float, WS_CSP + 524288), WSP(float, WS_CSP + 786432));
        else p0_transpose_item(W, DM, DM, WT, scr, r, 64, C.lane);
    }
    p0_convert(C, AIN(I_X), WSP(bf16_t, WS_XN), (long)NT * DM / 8);
    p0_convert(C, AIN(I_MEM), WSP(bf16_t, WS_MEMB), (long)NMEM * DM / 8);
    p0_convert(C, AIN(I_PSK), WSP(bf16_t, WS_SK), 8L * 2 * 128 * 128 / 8);
}
__device__ __forceinline__ void phase1(unsigned char* lds_raw, int wave_s) {
    const Ctx C = mk_ctx(lds_raw, wave_s); const ArgsP A = get_args(); unsigned char* ws = (unsigned char*)A->ws;
    { pg8::PlainOrder S; S.init(WSP(bf16_t, WS_XN), WSP(bf16_t, WS_WIN), DM, DM, NT, NPAD, C.G, C.bx); pg8::EpiH E{WSP(bf16_t, WS_H), WSP(float, WS_GATES)};
      pg8::gemm_phase(C.lds, C.tid, C.wave, pg8::Gemm{DM, DM, DM}, S, E); }
    { pg8::PlainOrder S; S.init(WSP(bf16_t, WS_MEMB), WSP(bf16_t, WS_XWK), DM, DM, NMEM, DM, C.G, C.bx, 192); pg8::EpiBf16 E{WSP(bf16_t, WS_K2), DM, 1.0f};
      pg8::gemm_phase(C.lds, C.tid, C.wave, pg8::Gemm{DM, DM, DM}, S, E); }
    { pg8::PlainOrder S; S.init(WSP(bf16_t, WS_MEMB), WSP(bf16_t, WS_XWV), DM, DM, NMEM, DM, C.G, C.bx, 224); pg8::EpiBf16 E{WSP(bf16_t, WS_V2T), DM, 1.0f};
      pg8::gemm_phase(C.lds, C.tid, C.wave, pg8::Gemm{DM, DM, DM}, S, E); }
}
constexpr int CW_KRDY = 1024;
__device__ __forceinline__ void phase3a(unsigned char* lds_raw, int wave_s) {
    const Ctx C = mk_ctx(lds_raw, wave_s); const ArgsP A = get_args(); unsigned char* ws = (unsigned char*)A->ws;
    pass_knormrope(C, WSP(bf16_t, WS_H), AIN(I_AKN));
    VM_WAIT(); __syncthreads();
    if (C.tid == 0) { __builtin_amdgcn_fence(__ATOMIC_RELEASE, "agent"); VM_WAIT(); (void)xb_add(WSP(unsigned, WS_CTL) + CW_KRDY, 1u); }
    bf16_t* HF = (bf16_t*)AOUT; bf16_t* HBk = (bf16_t*)AOUT + (size_t)NT * 1024;
    for (int it = C.vcu; it < 256; it += C.G) { mlstm::item(C, it, WSP(bf16_t, WS_H), WSP(float, WS_GATES), AIN(I_BIG), AIN(I_BFG), HF, HBk); __syncthreads(); }
}
__device__ __forceinline__ void phase3b(unsigned char* lds_raw, int wave_s) {
    const Ctx C = mk_ctx(lds_raw, wave_s); const ArgsP A = get_args(); unsigned char* ws = (unsigned char*)A->ws;
    if (C.tid == 0) { unsigned sp = 0u; while (xb_ld(WSP(unsigned, WS_CTL) + CW_KRDY) < (unsigned)C.G) { __builtin_amdgcn_s_sleep(2); if (++sp > (1u << 22)) break; } __builtin_amdgcn_fence(__ATOMIC_ACQUIRE, "agent"); VM_WAIT(); }
    __syncthreads();
    bf16_t* Hb = WSP(bf16_t, WS_H); bf16_t* XN = WSP(bf16_t, WS_CC);
    for (int k = C.vcu; k < 512; k += C.G) {
        const int g8 = (k & 255) >> 5, idx = (k & 31) + 32 * (k >> 8);
        const int b = g8 >> 1, kvh = g8 & 1, qh = kvh * 4 + (idx >> 4), qb = idx & 15;
        const bf16_t* Qb = Hb + (size_t)(b * SEQ + qb * 256) * HP + C_AQ + qh * 128;
        const bf16_t* Kh = Hb + (size_t)(b * SEQ) * HP + C_AK + kvh * 128; const bf16_t* Vh = Hb + (size_t)(b * SEQ) * HP + C_AV + kvh * 128;
        bf16_t* Ob = XN + (size_t)(b * SEQ + qb * 256) * DM + qh * 128;
        attn::attn_dense_body(Qb, Kh, Vh, Ob, SEQ, (char*)lds_raw, C.tid, C.wave, AIN(I_AQN), qb * 256);
        __syncthreads();
    }
}
struct OneUnit { pg8::Unit u; __device__ bool next(int i, pg8::Unit& o) const { if (i) return false; o = u; return true; } };
__device__ __forceinline__ void phase4(unsigned char* lds_raw, int wave_s) { const Ctx C = mk_ctx(lds_raw, wave_s); const ArgsP A = get_args(); unsigned char* ws = (unsigned char*)A->ws;
    pass_mlpost(C, (const bf16_t*)AOUT, (const bf16_t*)AOUT + (size_t)NT * 1024, WSP(bf16_t, WS_H), AIN(I_MLN), WSP(bf16_t, WS_CC));
    for (int i = C.vcu * NTHREADS + C.tid; i < 4 * 2048; i += C.G * NTHREADS) { const float* pp = WSP(float, WS_CSP) + (size_t)(i >> 11) * 65536 + (i & 2047); float s = 0.f;
        for (int kb = 0; kb < 32; ++kb) s += pp[kb * 2048];
        WSP(float, WS_CS)[i] = s; }
    for (int L = C.bx; L < 256; L += C.G) { const int q = L & 127, b = q >> 5, h = (q >> 3) & 3, t8 = q & 7; const bool isv = L >= 128;
        OneUnit S; pg8::EpiBf16 E{nullptr, 0, 1.0f};
        if (!isv) { S.u.pm = b * 4 + h; S.u.pn = t8; S.u.a = (const char*)(WSP(bf16_t, WS_K2) + (size_t)(b * 256) * DM + h * 512); S.u.b = (const char*)(WSP(bf16_t, WS_WQN) + (size_t)(t8 * 256) * DM + h * 512); E.O = WSP(bf16_t, WS_MT); E.ldc = DM; }
        else { S.u.pm = b * 8 + t8; S.u.pn = h; S.u.a = (const char*)(WSP(bf16_t, WS_XWO) + (size_t)(t8 * 256) * DM + h * 512); S.u.b = (const char*)(WSP(bf16_t, WS_V2T) + (size_t)(b * 256) * DM + h * 512); E.O = WSP(bf16_t, WS_VWT); E.ldc = 1024; }
        int K = 512; asm volatile("" : "+s"(K));
        pg8::gemm_phase(C.lds, C.tid, C.wave, pg8::Gemm{DM, DM, K}, S, E); } }
#define LNTAB ((LAS f32x2*)(C.lds + LDSCTL_OFF + 1024))
__device__ __forceinline__ void phase5(unsigned char* lds_raw, int wave_s) {
    const Ctx C = mk_ctx(lds_raw, wave_s); const ArgsP A = get_args(); unsigned char* ws = (unsigned char*)A->ws;
    for (int o = C.gw; o < 4096; o += C.NGW) { const int b = o >> 10, j = o & 1023, h = j >> 8, key = j & 255;
        const u32x4 kv = *(const u32x4*)(WSP(bf16_t, WS_K2) + (size_t)(b * 256 + key) * DM + h * 512 + 8 * C.lane);
        const float* c1 = WSP(float, WS_CS) + h * 512 + 8 * C.lane; const float* b1 = c1 + 2048;
        const f32x4 ca = *(const f32x4*)c1, cb = *(const f32x4*)(c1 + 4), ba = *(const f32x4*)b1, bb = *(const f32x4*)(b1 + 4);
        const float k0 = bflo(kv.x), k1 = bfhi(kv.x), k2 = bflo(kv.y), k3 = bfhi(kv.y), k4 = bflo(kv.z), k5 = bfhi(kv.z), k6 = bflo(kv.w), k7 = bfhi(kv.w);
        float s1 = (k0 * ca[0] + k1 * ca[1]) + (k2 * ca[2] + k3 * ca[3]) + (k4 * cb[0] + k5 * cb[1]) + (k6 * cb[2] + k7 * cb[3]);
        float s2 = (k0 * ba[0] + k1 * ba[1]) + (k2 * ba[2] + k3 * ba[3]) + (k4 * bb[0] + k5 * bb[1]) + (k6 * bb[2] + k7 * bb[3]);
        s1 = wave_sum(s1); s2 = wave_sum(s2);
        if (C.lane == 0) { WSP(float, WS_CS2)[o] = s1; WSP(float, WS_CS2)[4096 + o] = s2; } }
    pg8::PlainOrder S; S.init(WSP(bf16_t, WS_CC), WSP(bf16_t, WS_WOUT), DM, DM, NT, DM, C.G, C.bx);
    pg8::EpiResStats<2> E{(const float*)WSP(bf16_t, WS_XN), WSP(bf16_t, WS_ZB), WSP(f32x2, WS_ST1), nullptr, 0, nullptr, nullptr, ALPHA};
    pg8::gemm_phase(C.lds, C.tid, C.wave, pg8::Gemm{DM, DM, DM}, S, E);
}
__device__ __forceinline__ void phase_lnfold(unsigned char* lds_raw, int wave_s, size_t offB, size_t offO, size_t offST, size_t offCS) {
    const Ctx C = mk_ctx(lds_raw, wave_s); const ArgsP A = get_args(); unsigned char* ws = (unsigned char*)A->ws;
    pg8::PlainOrder S; S.init(WSP(bf16_t, WS_ZB), WSP(bf16_t, offB), DM, DM, NT, DM, C.G, C.bx);
    const int pm0 = pg8::ln_build_tables(WSP(f32x2, offST), S, C.tid, LNTAB);
    pg8::EpiLnFold E{WSP(bf16_t, offO), DM, LNTAB, pm0, WSP(float, offCS), WSP(float, offCS + 8192)};
    pg8::gemm_phase(C.lds, C.tid, C.wave, pg8::Gemm{DM, DM, DM}, S, E);
}
struct TwoUnits { pg8::Unit u0, u1; __device__ bool next(int i, pg8::Unit& o) const { if (i > 1) return false; o = i ? u1 : u0; return true; } };
__device__ __forceinline__ void phase_xattn(unsigned char* lds_raw, int wave_s) {
    { const Ctx C = mk_ctx(lds_raw, wave_s); const ArgsP A = get_args(); unsigned char* ws = (unsigned char*)A->ws;
      const bf16_t* Q2 = WSP(bf16_t, WS_Q2); const bf16_t* K2 = WSP(bf16_t, WS_K2); bf16_t* P = WSP(bf16_t, WS_XN);
      LAS float* tmax = (LAS float*)(C.lds + LDSCTL_OFF + 1024); LAS float* tsum = tmax + 1024;
      for (int L = C.bx; L < 256; L += C.G) { const int pm = L >> 2, h = L & 3;
          OneUnit S; S.u.pm = pm; S.u.pn = h; S.u.a = (const char*)(Q2 + (size_t)pm * 256 * DM + h * 512); S.u.b = (const char*)(K2 + (size_t)(pm >> 4) * 256 * DM + h * 512);
          pg8::EpiSoftmaxP E{P, 1024, 0.04419417382415922f, tmax, tsum}; int K = 512; asm volatile("" : "+s"(K));
          pg8::gemm_phase(C.lds, C.tid, C.wave, pg8::Gemm{DM, DM, K}, S, E); }
      VM_WAIT(); __syncthreads();
      if (C.tid == 0) { __builtin_amdgcn_fence(__ATOMIC_ACQUIRE, "agent"); VM_WAIT(); }
      __syncthreads(); }
    { const Ctx C = mk_ctx(lds_raw, wave_s); const ArgsP A = get_args(); unsigned char* ws = (unsigned char*)A->ws;
      const bf16_t* P = WSP(bf16_t, WS_XN); const bf16_t* V2T = WSP(bf16_t, WS_V2T);
      for (int L = C.bx; L < 256; L += C.G) { const int pm = L >> 2, h = L & 3;
          TwoUnits S; S.u0.pm = pm; S.u0.pn = 2 * h; S.u0.a = (const char*)(P + (size_t)pm * 256 * 1024 + h * 256); S.u0.b = (const char*)(V2T + (size_t)(2 * h) * 256 * 1024 + (pm >> 4) * 256);
          S.u1 = S.u0; S.u1.pn = 2 * h + 1; S.u1.b = (const char*)(V2T + (size_t)(2 * h + 1) * 256 * 1024 + (pm >> 4) * 256);
          pg8::EpiBf16 E{WSP(bf16_t, WS_O2), DM, 1.0f}; int K = 256; asm volatile("" : "+s"(K));
          pg8::gemm_phase(C.lds, C.tid, C.wave, pg8::Gemm{1024, 1024, K}, S, E); } }
}
__device__ __forceinline__ void phase8(unsigned char* lds_raw, int wave_s) {
    const Ctx C = mk_ctx(lds_raw, wave_s); const ArgsP A = get_args(); unsigned char* ws = (unsigned char*)A->ws;
    SGemmOrder S{WSP(bf16_t, WS_Q2), WSP(bf16_t, WS_K2), C.G, C.bx}; pg8::EpiF32 E{AOUT, 1024, 0.04419417382415922f};
    int K = 512; asm volatile("" : "+s"(K));
    pg8::gemm_phase(C.lds, C.tid, C.wave, pg8::Gemm{DM, DM, K}, S, E);
}
__device__ __forceinline__ void phase9(unsigned char* lds_raw, int wave_s) { const Ctx C = mk_ctx(lds_raw, wave_s); const ArgsP A = get_args(); unsigned char* ws = (unsigned char*)A->ws; pass_softmax(C, AOUT, WSP(bf16_t, WS_XN)); }
__device__ __forceinline__ void phase10(unsigned char* lds_raw, int wave_s) {
    const Ctx C = mk_ctx(lds_raw, wave_s); const ArgsP A = get_args(); unsigned char* ws = (unsigned char*)A->ws;
    PVGemmOrder S{WSP(bf16_t, WS_XN), WSP(bf16_t, WS_V2T), C.G, C.bx}; pg8::EpiBf16 E{WSP(bf16_t, WS_O2), DM, 1.0f};
    int K = 256; asm volatile("" : "+s"(K));
    pg8::gemm_phase(C.lds, C.tid, C.wave, pg8::Gemm{1024, 1024, K}, S, E);
}
__device__ __forceinline__ void phase_scores(unsigned char* lds_raw, int wave_s) {
    const Ctx C = mk_ctx(lds_raw, wave_s); const ArgsP A = get_args(); unsigned char* ws = (unsigned char*)A->ws;
    LAS f32x2* lntab = (LAS f32x2*)(C.lds + LDSCTL_OFF + 1024); LAS float* tmax = (LAS float*)(C.lds + LDSCTL_OFF + 1024 + 2048); LAS float* tsum = tmax + 1024;
    for (int L = C.bx; L < 256; L += C.G) { const int pm = L >> 2, h = L & 3, b = pm >> 4;
        pg8::ln_build_table(WSP(f32x2, WS_ST1), pm, C.tid, lntab); LDS_WAIT(); __syncthreads();
        OneUnit S; S.u.pm = pm; S.u.pn = h; S.u.a = (const char*)(WSP(bf16_t, WS_ZB) + (size_t)pm * 256 * DM); S.u.b = (const char*)(WSP(bf16_t, WS_MT) + (size_t)(b * 1024 + h * 256) * DM);
        pg8::EpiLnSoftmaxP E{pg8::EpiSoftmaxP{WSP(bf16_t, WS_XN), 1024, 0.04419417382415922f, tmax, tsum}, lntab, WSP(float, WS_CS2) + b * 1024, WSP(float, WS_CS2) + 4096 + b * 1024};
        pg8::gemm_phase(C.lds, C.tid, C.wave, pg8::Gemm{DM, DM, DM}, S, E); __syncthreads(); }
}
__device__ __forceinline__ void phase11(unsigned char* lds_raw, int wave_s) {
    const Ctx C = mk_ctx(lds_raw, wave_s); const ArgsP A = get_args(); unsigned char* ws = (unsigned char*)A->ws;
    pg8::BatchOrder S; S.init(WSP(bf16_t, WS_XN), WSP(bf16_t, WS_VWT), 1024, 1024, NT, DM, C.G, C.bx); S.bstride = (size_t)2048 * 1024 * 2;
    const int pm0 = pg8::ln_build_tables(WSP(f32x2, WS_ST1), S, C.tid, LNTAB);
    pg8::EpiResStats<1> E{nullptr, WSP(bf16_t, WS_ZB), WSP(f32x2, WS_ST2), LNTAB, pm0, AIN(I_LN1G), AIN(I_LN1B), ALPHA};
    int K = 1024; asm volatile("" : "+s"(K));
    pg8::gemm_phase(C.lds, C.tid, C.wave, pg8::Gemm{1024, 1024, K}, S, E);
}
__device__ __forceinline__ void phase14(unsigned char* lds_raw, int wave_s) {
    const Ctx C = mk_ctx(lds_raw, wave_s); const ArgsP A = get_args(); unsigned char* ws = (unsigned char*)A->ws;
    const bool p8 = (C.G % 8) == 0; const int nh = p8 ? 1 : 8, ngrp = p8 ? C.G / 8 : C.G, g = p8 ? C.bx / 8 : C.bx;
    LAS bf16_t* skl = (LAS bf16_t*)(C.lds + 65536);
    for (int hq = 0; hq < nh; ++hq) { const int h = p8 ? (C.bx & 7) : hq;
        __syncthreads();
#pragma unroll
        for (int r = 0; r < 8; ++r) { const int q = r * NTHREADS + C.tid, c = q >> 11, key = (q >> 4) & 127, ch = q & 15;
            *(LAS u32x4*)(skl + (c * 128 + key) * peer::SKP + ch * 8) = *(const u32x4*)(WSP(bf16_t, WS_SK) + ((size_t)((h * 2 + c) * 128 + key)) * 128 + ch * 8); }
        LDS_WAIT(); __syncthreads();
        for (int tb = g + ngrp * C.wave; tb < NT / 32; tb += ngrp * NWAVES)
            peer::route_unit(C.lane, tb * 32, h, WSP(bf16_t, WS_PQ), skl, WSP(int, WS_EXP), WSP(float, WS_PG), (LAS unsigned*)(C.lds + C.wave * 8192)); }
}
__device__ __forceinline__ void phase15(unsigned char* lds_raw, int wave_s, bool dummy = false) {
    const Ctx C = mk_ctx(lds_raw, wave_s); const ArgsP A = get_args(); unsigned char* ws = (unsigned char*)A->ws;
    for (int tok = C.gw; tok < NT; tok += C.NGW) peer::gather_token(C.lane, tok, WSP(f32x2, WS_ST2), AIN(I_LN2G), AIN(I_LN2B), WSP(bf16_t, WS_ZB), AOUT, WSP(unsigned char, WS_UB), WSP(unsigned char, WS_VB), WSP(float, WS_USC), WSP(float, WS_VSC), WSP(int, WS_EXP), WSP(float, WS_PG), AIN(I_LN3G), AIN(I_LN3B));
}

__device__ __forceinline__ void fwd_body(const int lo, const int hi, unsigned char* lds_raw) {
    const int wave_s = __builtin_amdgcn_readfirstlane((int)threadIdx.x >> 6);
    const bool multi = (hi - lo) > 1;
    volatile LAS unsigned* st = (volatile LAS unsigned*)((LAS unsigned char*)lds_raw + LDSCTL_OFF);
#define LEADER() (wave_s == 0 && lane_now() == 0u)

    XcdBarrier bar; bar.bar = nullptr; bar.x = 0; bar.st = st;
    if (multi) { if (LEADER()) { st[0] = 0u; st[1] = 0u; } __syncthreads(); bar = xcd_barrier_post((unsigned*)get_args()->ws + CW_BAR, st, LEADER()); }
#define IN(k) (lo <= (k) && (k) < hi)
#if MK_CG_SYNC
    cg::grid_group grid = cg::this_grid();
#define SEAM(k) do { if (multi && (k) + 1 < hi) { __syncthreads(); grid.sync(); } } while (0)
#else
#define SEAM(k) do { if (multi && (k) + 1 < hi) { xcd_barrier(bar, LEADER()); } } while (0)
#endif
    if (IN(0)) { phase0(lds_raw, wave_s); if (DUP(0)) phase0(lds_raw, wave_s); SEAM(0); }
    if (IN(1)) { phase1(lds_raw, wave_s); if (DUP(1)) phase1(lds_raw, wave_s); SEAM(1); }
    if (IN(3)) { phase3a(lds_raw, wave_s); if (DUP(16)) phase3a(lds_raw, wave_s); phase3b(lds_raw, wave_s); if (DUP(17)) phase3b(lds_raw, wave_s); SEAM(3); }
    if (IN(4)) { phase4(lds_raw, wave_s); if (DUP(4)) phase4(lds_raw, wave_s); SEAM(4); }
    if (IN(5)) { phase5(lds_raw, wave_s); if (DUP(5)) phase5(lds_raw, wave_s); SEAM(5); }
    if (IN(7)) { phase_scores(lds_raw, wave_s); if (DUP(7)) phase_scores(lds_raw, wave_s); SEAM(7); }
    if (IN(11)) { phase11(lds_raw, wave_s); SEAM(11); }
    if (IN(13)) { phase_lnfold(lds_raw, wave_s, WS_PWQ, WS_PQ, WS_ST2, WS_CS + 16384); SEAM(13); }
    if (IN(14)) { phase14(lds_raw, wave_s); if (DUP(14)) phase14(lds_raw, wave_s); SEAM(14); }
    if (IN(15)) { if (DUP(15)) phase15(lds_raw, wave_s, true); phase15(lds_raw, wave_s); }
#undef IN
#undef SEAM
}
#if MK_ONE_LAUNCH
__global__ void __launch_bounds__(NTHREADS, 2) fwd_kernel(Args args) {
    extern __shared__ __attribute__((aligned(16))) unsigned char lds_dyn[];
    fwd_body(args.ph_lo, args.ph_hi, lds_dyn);
}
#endif
#if !MK_ONE_LAUNCH
template <int PH> __global__ void __launch_bounds__(NTHREADS, 2) phase_kernel(Args args) {
    extern __shared__ __attribute__((aligned(16))) unsigned char lds_dyn[];
    fwd_body(PH, PH + 1, lds_dyn);
}

#endif
#if MK_ONE_LAUNCH
#define OCC_FN ((const void*)fwd_kernel)
#else
#define OCC_FN phase_fn(3)
static const void* phase_fn(int ph) {
    switch (ph) {
        case 0: return (const void*)phase_kernel<0>; case 1: return (const void*)phase_kernel<1>; case 2: return (const void*)phase_kernel<2>; case 3: return (const void*)phase_kernel<3>;
        case 4: return (const void*)phase_kernel<4>; case 5: return (const void*)phase_kernel<5>; case 6: return (const void*)phase_kernel<6>; case 7: return (const void*)phase_kernel<7>;
        case 8: return (const void*)phase_kernel<8>; case 9: return (const void*)phase_kernel<9>; case 10: return (const void*)phase_kernel<10>; case 11: return (const void*)phase_kernel<11>;
        case 12: return (const void*)phase_kernel<12>; case 13: return (const void*)phase_kernel<13>; case 14: return (const void*)phase_kernel<14>; default: return (const void*)phase_kernel<15>;
    }
}
#endif
extern "C" void kernel_launch(void* const* d_in, const int* in_sizes, int n_in, void* d_out, int out_size, void* d_ws, size_t ws_size, hipStream_t stream) {
    static int grid = 0;
    if (grid == 0) {
        if (n_in != 23 || in_sizes[0] != NT * DM || out_size != NT * DM || ws_size < WS_END) {
            fprintf(stderr, "kernel_launch: built for 23 inputs, x/out of %d floats, >= %zu bytes of workspace; got n_in %d, in0 %d, out %d, ws %zu\n", NT * DM, (size_t)WS_END, n_in, n_in > 0 ? in_sizes[0] : -1, out_size, ws_size);
            grid = -1; return; }
        int dev = 0, cus = 0, per_cu = 0;
        if (hipGetDevice(&dev) != hipSuccess || hipDeviceGetAttribute(&cus, hipDeviceAttributeMultiprocessorCount, dev) != hipSuccess) { grid = -1; return; }
#if MK_ONE_LAUNCH
        if (hipFuncSetAttribute((const void*)fwd_kernel, hipFuncAttributeMaxDynamicSharedMemorySize, LDS_BYTES) != hipSuccess) { fprintf(stderr, "kernel_launch: hipFuncSetAttribute failed\n"); grid = -1; return; }
#else
        for (int ph = 0; ph < NPH; ++ph) if (hipFuncSetAttribute(phase_fn(ph), hipFuncAttributeMaxDynamicSharedMemorySize, LDS_BYTES) != hipSuccess) { fprintf(stderr, "kernel_launch: hipFuncSetAttribute failed\n"); grid = -1; return; }
#endif
        if (hipOccupancyMaxActiveBlocksPerMultiprocessor(&per_cu, OCC_FN, NTHREADS, LDS_BYTES) != hipSuccess || per_cu < 1) {
            fprintf(stderr, "kernel_launch: occupancy query reports %d workgroups per CU\n", per_cu); (void)hipGetLastError(); }
        grid = cus;
        if (grid != 256) fprintf(stderr, "kernel_launch: %d CUs (tuned for 256)\n", grid);
    }
    if (grid < 0) return;
    (void)hipMemsetAsync((char*)d_ws + WS_CTL, 0, CTL_ZERO_BYTES, stream);
    Args a{};
    for (int i = 0; i < 23; ++i) a.in[i] = (GAS const float*)d_in[i];
    a.out = (GAS float*)d_out; a.ws = (GAS unsigned char*)d_ws;
#if MK_ONE_LAUNCH
    a.ph_lo = 0; a.ph_hi = NPH;
    void* kargs[] = {&a};
    hipError_t e = hipLaunchCooperativeKernel((const void*)fwd_kernel, dim3(grid), dim3(NTHREADS), kargs, LDS_BYTES, stream);
    if (e != hipSuccess) fprintf(stderr, "kernel_launch: cooperative launch failed: %s (grid %d)\n", hipGetErrorString(e), grid);
#else
    for (int ph = 0; ph < NPH; ++ph) {
        a.ph_lo = ph; a.ph_hi = ph + 1;
        void* kargs[] = {&a};
        (void)hipLaunchKernel(phase_fn(ph), dim3(grid), dim3(NTHREADS), kargs, LDS_BYTES, stream);
    }
    const hipError_t le = hipPeekAtLastError();
    if (le != hipSuccess) fprintf(stderr, "kernel_launch: launch failed: %s\n", hipGetErrorName(le));
#endif
}
```
